# Optimizing an MI355X kernel written in HIP

```python
import math
import jax
import jax.numpy as jnp
from jax import lax
import numpy as np

D_MODEL = 1024
BATCH = 2
SEQ = 8192
DEPTH = 2

CTX_LEN = 256
GRID_W = 64
N_MIXERS = 2
N_HGRN_LAYERS = (DEPTH + N_MIXERS - 1) // N_MIXERS
N_DIFF_LAYERS = DEPTH // N_MIXERS
HGRN_HEADS = 8
HGRN_EXPAND = 128
HGRN_FDIM = HGRN_HEADS * HGRN_EXPAND
HGRN_HEAD_V = D_MODEL // HGRN_HEADS
CHUNK = 64
DIFF_HEADS = 8
DIFF_HEAD_DIM = D_MODEL // DIFF_HEADS // 2
ROPE_BASE = 10000.0
ROPE_PAIRS_PER_AXIS = DIFF_HEAD_DIM // 4
Q_BLOCK = 128
N_EXPERTS = 16
EC_CAPACITY_FACTOR = 2
D_EXPERT = 2816
NORM_EPS = 1e-6

kernel_name = "hybrid_hgrn2_diffattn_ecmoe_dit"


def _rmsnorm(x, g):
    xf = x.astype(jnp.float32)
    y = xf * lax.rsqrt(jnp.mean(xf * xf, axis=-1, keepdims=True) + NORM_EPS)
    return (y * g.astype(jnp.float32)).astype(x.dtype)


def _gla_step(S, inp):
    q, k, v, lf = inp
    b = jnp.cumsum(lf, axis=2)
    tril = jnp.tril(jnp.ones((CHUNK, CHUNK), dtype=bool))
    o_inter = jnp.einsum('bhtk,bhkv->bhtv', q * jnp.exp(b), S)
    rel = b[:, :, :, None, :] - b[:, :, None, :, :]
    decay = jnp.exp(jnp.where(tril[:, :, None], rel, -jnp.inf))
    a = jnp.einsum('bhtk,bhsk,bhtsk->bhts', q, k, decay)
    o = o_inter + jnp.einsum('bhts,bhsv->bhtv', a, v)
    b_last = b[:, :, -1:, :]
    S_new = jnp.exp(b_last[:, :, 0, :])[..., None] * S + jnp.einsum(
        'bhsk,bhsv->bhkv', k * jnp.exp(b_last - b), v)
    return S_new, o


def _gla_chunked(q, k, v, lf, S0):
    B, T, H, _ = q.shape
    V = v.shape[-1]
    n = T // CHUNK

    def to_blocks(t):
        return t.reshape(B, n, CHUNK, H, t.shape[-1]).transpose(1, 0, 3, 2, 4)

    S, o = lax.scan(_gla_step, S0, (to_blocks(q), to_blocks(k), to_blocks(v), to_blocks(lf)))
    return S, o.transpose(1, 0, 3, 2, 4).reshape(B, T, H, V)


def _hgrn2_mixer(h_ctx, h_lat, w_in, lb, norm_g, w_out):
    splits = [HGRN_FDIM, 2 * HGRN_FDIM, 3 * HGRN_FDIM, 3 * HGRN_FDIM + D_MODEL]

    def project(h):
        B, T, _ = h.shape
        q, f_fw, f_bw, v, g = jnp.split(h @ w_in, splits, axis=-1)
        hd = lambda t, d: t.reshape(B, T, HGRN_HEADS, d).astype(jnp.float32)
        return (jax.nn.silu(hd(q, HGRN_EXPAND)), hd(f_fw, HGRN_EXPAND), hd(f_bw, HGRN_EXPAND),
                hd(v, HGRN_HEAD_V), g)

    def gates(f_logit):
        f = lb + (1.0 - lb) * jax.nn.sigmoid(f_logit)
        return jnp.log(f), 1.0 - f

    qc, fc_fw, fc_bw, vc, gc = project(h_ctx)
    ql, fl_fw, fl_bw, vl, gl = project(h_lat)
    B = h_lat.shape[0]

    def direction(fc, fl, reverse):
        lfc, kc = gates(fc)
        lfl, kl = gates(fl)
        flip = (lambda t: jnp.flip(t, axis=1)) if reverse else (lambda t: t)
        S0 = jnp.zeros((B, HGRN_HEADS, HGRN_EXPAND, HGRN_HEAD_V), jnp.float32)
        S_ctx, oc = _gla_chunked(flip(qc), flip(kc), flip(vc), flip(lfc), S0)
        _, ol = _gla_chunked(flip(ql), flip(kl), flip(vl), flip(lfl), S_ctx)
        return flip(oc), flip(ol)

    oc_f, ol_f = direction(fc_fw, fl_fw, False)
    oc_b, ol_b = direction(fc_bw, fl_bw, True)

    def readout(o, g):
        Bo, T = o.shape[:2]
        o = _rmsnorm(o, norm_g) * jax.nn.silu(g.astype(jnp.float32)).reshape(
            Bo, T, HGRN_HEADS, HGRN_HEAD_V)
        return o.reshape(Bo, T, D_MODEL).astype(g.dtype) @ w_out

    return readout(oc_f + oc_b, gc), readout(ol_f + ol_b, gl)


def _axial_rope_tables(T):
    rows = T // GRID_W
    row = jnp.repeat(jnp.arange(rows, dtype=jnp.float32), GRID_W)
    col = jnp.tile(jnp.arange(GRID_W, dtype=jnp.float32), rows)
    freq = ROPE_BASE ** (-jnp.arange(ROPE_PAIRS_PER_AXIS, dtype=jnp.float32) / ROPE_PAIRS_PER_AXIS)
    ang = jnp.concatenate([row[:, None] * freq, col[:, None] * freq], axis=-1)
    return jnp.cos(ang), jnp.sin(ang)


def _apply_rope(x, cos, sin):
    c = cos[None, :, None, None, :]
    s = sin[None, :, None, None, :]
    x1, x2 = jnp.split(x, 2, axis=-1)
    return jnp.concatenate([x1 * c - x2 * s, x2 * c + x1 * s], axis=-1)


def _diff_scores(qb, keys, vals, lam):
    s = jnp.einsum('bqhcd,bkhcd->bhcqk', qb, keys) * (DIFF_HEAD_DIM ** -0.5)
    p = jax.nn.softmax(s, axis=-1)
    w = p[:, :, 0] - lam * p[:, :, 1]
    return jnp.einsum('bhqk,bkhv->bqhv', w, vals)


def _diff_attention(h_ctx, h_lat, w_in, lam_vecs, subln_g, w_out, lam_init, need_ctx):
    def project(h):
        B, T, _ = h.shape
        q, k, v = jnp.split(h @ w_in, 3, axis=-1)
        q = q.reshape(B, T, DIFF_HEADS, 2, DIFF_HEAD_DIM).astype(jnp.float32)
        k = k.reshape(B, T, DIFF_HEADS, 2, DIFF_HEAD_DIM).astype(jnp.float32)
        v = v.reshape(B, T, DIFF_HEADS, 2 * DIFF_HEAD_DIM).astype(jnp.float32)
        return q, k, v

    qc, kc, vc = project(h_ctx)
    ql, kl, vl = project(h_lat)
    B, T = h_lat.shape[:2]
    cos, sin = _axial_rope_tables(T)
    ql = _apply_rope(ql, cos, sin)
    kl = _apply_rope(kl, cos, sin)
    lv = lam_vecs.astype(jnp.float32)
    lam = jnp.exp(jnp.sum(lv[0] * lv[1])) - jnp.exp(jnp.sum(lv[2] * lv[3])) + lam_init

    keys = jnp.concatenate([kc, kl], axis=1)
    vals = jnp.concatenate([vc, vl], axis=1)
    nb = T // Q_BLOCK
    qblk = ql.reshape(B, nb, Q_BLOCK, DIFF_HEADS, 2, DIFF_HEAD_DIM).transpose(1, 0, 2, 3, 4, 5)
    ol = lax.map(lambda qb: _diff_scores(qb, keys, vals, lam), qblk)
    ol = ol.transpose(1, 0, 2, 3, 4).reshape(B, T, DIFF_HEADS, 2 * DIFF_HEAD_DIM)

    def readout(o):
        Bo, To = o.shape[:2]
        o = _rmsnorm(o, subln_g) * (1.0 - lam_init)
        return o.reshape(Bo, To, D_MODEL).astype(h_lat.dtype) @ w_out

    y_lat = readout(ol)
    y_ctx = readout(_diff_scores(qc, kc, vc, lam)) if need_ctx else None
    return y_ctx, y_lat


def _ec_moe(h, w_router, w_gate, w_up, w_down):
    B, T, _ = h.shape
    cap = EC_CAPACITY_FACTOR * T // N_EXPERTS
    aff = jax.nn.softmax((h @ w_router).astype(jnp.float32), axis=-1)
    g, idx = lax.top_k(jnp.swapaxes(aff, 1, 2), cap)
    xs = jax.vmap(lambda hb, ib: hb[ib])(h, idx)
    a = jnp.einsum('becd,edf->becf', xs, w_gate)
    u = jnp.einsum('becd,edf->becf', xs, w_up)
    y = jnp.einsum('becf,efd->becd', jax.nn.silu(a) * u, w_down) * g[..., None].astype(h.dtype)
    bidx = jnp.arange(B)[:, None, None]
    return jnp.zeros_like(h).at[bidx, idx].add(y.astype(h.dtype))


def setup_inputs(seed: int = 0) -> dict:
    key = jax.random.key(seed)
    ks = jax.random.split(key, 24)
    nrm = lambda k, shape, s: jax.random.normal(k, shape, jnp.float32) * s
    D = D_MODEL
    return {
        "x": nrm(ks[0], (BATCH, SEQ, D), 1.0),
        "c": nrm(ks[1], (BATCH, D), 1.0),
        "ctx": nrm(ks[2], (BATCH, CTX_LEN, D), 1.0),
        "c_ctx": nrm(ks[3], (D,), 1.0),
        "ada_w": nrm(ks[4], (DEPTH, D, 6 * D), 0.5 * D ** -0.5),
        "ada_b": nrm(ks[5], (DEPTH, 6 * D), 0.02),
        "norm_mix": 1.0 + nrm(ks[6], (DEPTH, D), 0.05),
        "norm_ffn": 1.0 + nrm(ks[7], (DEPTH, D), 0.05),
        "norm_final": 1.0 + nrm(ks[8], (D,), 0.05),
        "hgrn_w_in": nrm(ks[9], (N_HGRN_LAYERS, D, 3 * HGRN_FDIM + 2 * D), D ** -0.5),
        "hgrn_lb_logits": nrm(ks[10], (N_HGRN_LAYERS + 1, HGRN_FDIM), 0.5),
        "hgrn_norm": 1.0 + nrm(ks[11], (N_HGRN_LAYERS, HGRN_HEAD_V), 0.05),
        "hgrn_w_out": nrm(ks[12], (N_HGRN_LAYERS, D, D), D ** -0.5),
        "diff_w_in": nrm(ks[13], (N_DIFF_LAYERS, D, 3 * D), D ** -0.5),
        "diff_lambda": nrm(ks[14], (N_DIFF_LAYERS, 4, DIFF_HEAD_DIM), 0.1),
        "diff_subln": 1.0 + nrm(ks[15], (N_DIFF_LAYERS, 2 * DIFF_HEAD_DIM), 0.05),
        "diff_w_out": nrm(ks[16], (N_DIFF_LAYERS, D, D), D ** -0.5),
        "moe_router": nrm(ks[17], (DEPTH, D, N_EXPERTS), D ** -0.5),
        "moe_w_gate": nrm(ks[18], (DEPTH, N_EXPERTS, D, D_EXPERT), D ** -0.5),
        "moe_w_up": nrm(ks[19], (DEPTH, N_EXPERTS, D, D_EXPERT), D ** -0.5),
        "moe_w_down": nrm(ks[20], (DEPTH, N_EXPERTS, D_EXPERT, D), D_EXPERT ** -0.5),
    }


def reference(x, c, ctx, c_ctx, ada_w, ada_b, norm_mix, norm_ffn, norm_final,
              hgrn_w_in, hgrn_lb_logits, hgrn_norm, hgrn_w_out,
              diff_w_in, diff_lambda, diff_subln, diff_w_out,
              moe_router, moe_w_gate, moe_w_up, moe_w_down):
    lower_bounds = jnp.cumsum(jax.nn.softmax(hgrn_lb_logits.astype(jnp.float32), axis=0), axis=0)
    silu_c = jax.nn.silu(c)
    silu_cc = jax.nn.silu(c_ctx)
    x_lat, x_ctx = x, ctx
    for i in range(DEPTH):
        last = i == DEPTH - 1
        j = i // N_MIXERS
        mod_l = (silu_c @ ada_w[i] + ada_b[i])[:, None, :]
        mod_c = (silu_cc @ ada_w[i] + ada_b[i])[None, None, :]
        sh_m, sc_m, gt_m, sh_f, sc_f, gt_f = jnp.split(mod_l, 6, axis=-1)
        csh_m, csc_m, cgt_m, csh_f, csc_f, cgt_f = jnp.split(mod_c, 6, axis=-1)

        h_lat = _rmsnorm(x_lat, norm_mix[i]) * (1.0 + sc_m) + sh_m
        h_ctx = _rmsnorm(x_ctx, norm_mix[i]) * (1.0 + csc_m) + csh_m
        if i % N_MIXERS == 0:
            lb = lower_bounds[j].reshape(HGRN_HEADS, HGRN_EXPAND)
            y_ctx, y_lat = _hgrn2_mixer(h_ctx, h_lat, hgrn_w_in[j], lb, hgrn_norm[j], hgrn_w_out[j])
        else:
            lam_init = 0.8 - 0.6 * math.exp(-0.3 * i)
            y_ctx, y_lat = _diff_attention(h_ctx, h_lat, diff_w_in[j], diff_lambda[j], diff_subln[j],
                                           diff_w_out[j], lam_init, not last)
        x_lat = x_lat + gt_m * y_lat
        h_lat = _rmsnorm(x_lat, norm_ffn[i]) * (1.0 + sc_f) + sh_f
        x_lat = x_lat + gt_f * _ec_moe(h_lat, moe_router[i], moe_w_gate[i], moe_w_up[i], moe_w_down[i])
        if not last:
            x_ctx = x_ctx + cgt_m * y_ctx
            h_ctx = _rmsnorm(x_ctx, norm_ffn[i]) * (1.0 + csc_f) + csh_f
            x_ctx = x_ctx + cgt_f * _ec_moe(h_ctx, moe_router[i], moe_w_gate[i], moe_w_up[i], moe_w_down[i])
    return _rmsnorm(x_lat, norm_final)
```

```cpp
#include <hip/hip_runtime.h>
#include <cstdio>
#include <cstdint>
namespace pg8 {
#define PG8_LAS __attribute__((address_space(3)))
typedef unsigned short bf16_t;
typedef short bf16x8 __attribute__((ext_vector_type(8)));
typedef float f32x4 __attribute__((ext_vector_type(4)));
typedef unsigned u32x4 __attribute__((ext_vector_type(4)));
constexpr int BM = 256, BK = 64, HALF = 128, HTB = HALF * BK * 2  , STAGE_BYTES = 8 * HTB, NXCD = 8, WGM = 8;

__host__ __device__ __forceinline__ int lds_byte(int r, int c) { const int st = (r >> 4) * 2 + (c >> 5), rr = r & 15, cc = c & 31, ob = rr * 64 + cc * 2; return st * 1024 + (ob ^ (((ob >> 9) & 1) << 5)); }
__host__ __device__ __forceinline__ void stage_rc(int b, int& R, int& C) { const int st = b / 1024, sb = b % 1024, swz = sb ^ (((sb >> 9) & 1) << 5); R = (st >> 1) * 16 + swz / 64; C = (st & 1) * 32 + (swz % 64) / 2; }
__host__ __device__ __forceinline__ int perm32(int rho) { const int n = rho >> 4, i = rho & 15; return 8 * (i >> 2) + 4 * n + (i & 3); }

struct Unit { int pm, pn, nt, kofs, flags; };
struct Gemm { const bf16_t* A; const bf16_t* Bt; int M, N, K; const int* rowidx; };

struct StaticOrder {
    int nM, nN, nwg, G, c;
    __host__ __device__ __forceinline__ void init(int M, int N, int G_, int c_) { nM = M / BM; nN = N / BM; nwg = nM * nN; G = G_; c = c_; }
    __host__ __device__ __forceinline__ bool next(int i, Unit& u) const {
        const long L = (long)i * G + c; if (L >= nwg) return false;
        int wgid = (int)L; { const int q = nwg / NXCD, r = nwg % NXCD, xcd = wgid % NXCD, off = wgid / NXCD; wgid = (xcd < r ? xcd * (q + 1) : r * (q + 1) + (xcd - r) * q) + off; }
        const int nig = WGM * nN, gid = wgid / nig, fm = gid * WGM, gsz = (nM - fm) < WGM ? (nM - fm) : WGM;
        u.pm = fm + ((wgid % nig) % gsz); u.pn = (wgid % nig) / gsz; return true;
    }
    __device__ __forceinline__ void a_ready(const Unit&) const {}
    __device__ __forceinline__ void done(const Unit&) const {}
};

typedef float f32x2c_t __attribute__((ext_vector_type(2))); typedef __bf16 bf16x2c_t __attribute__((ext_vector_type(2)));
__device__ __forceinline__ unsigned cvt_pk_bf16(float lo, float hi) { const f32x2c_t v = {lo, hi}; const bf16x2c_t c = __builtin_convertvector(v, bf16x2c_t); return __builtin_bit_cast(unsigned, c); }
typedef float f32x2 __attribute__((ext_vector_type(2)));
template <class Epi, class Sched, bool ALIGN_EPI = false, bool SP2 = false, bool GATHER = false>
__device__ __forceinline__ void gemm_phase(PG8_LAS unsigned char* lds, const Gemm g, const Sched& S, const Epi& E) {
    const int tid = threadIdx.x, wid = __builtin_amdgcn_readfirstlane(tid >> 6), lane = tid & 63, wr = wid >> 2, wc = wid & 3, fr = lane & 15, fq = lane >> 4;
    const int K = g.K; int nt = K / BK;
    unsigned voffA[2], voffB[2];
#pragma unroll
    for (int i = 0; i < 2; ++i) { int R, C; stage_rc(tid * 16 + i * 8192, R, C); const int Rb = Epi::PERM ? ((R & ~31) + perm32(R & 31)) : R;
        voffA[i] = (unsigned)(R * K + C) * 2u; voffB[i] = (unsigned)(Rb * K + C) * 2u; }
    int gR[2], gC[2];
#pragma unroll
    for (int i = 0; i < 2; ++i) stage_rc(tid * 16 + i * 8192, gR[i], gC[i]);
    unsigned oc0[2] = {0u, 0u}, oc1[2] = {0u, 0u}, on0[2] = {0u, 0u}, on1[2] = {0u, 0u};
    PG8_LAS unsigned short* ridx = (PG8_LAS unsigned short*)(lds + STAGE_BYTES);
#define PG8_GOFF(o0, o1, uu, ord) do { _Pragma("unroll") for (int _i = 0; _i < 2; ++_i) { const int _lim = ((uu).flags & 1) ? 64 : 256; \
        const int _r0 = gR[_i], _r1 = HALF + gR[_i]; const int _i0 = _r0 < _lim ? (int)ridx[(ord) * 256 + _r0] : 0, _i1 = _r1 < _lim ? (int)ridx[(ord) * 256 + _r1] : 0; \
        o0[_i] = (unsigned)(_i0 * K + gC[_i]) * 2u; o1[_i] = (unsigned)(_i1 * K + gC[_i]) * 2u; } } while (0)
    const size_t kstep = (size_t)(BK * 2);
    const size_t hstep = (size_t)HALF * K * 2;
    const size_t hA = GATHER ? 0 : hstep;
    const size_t tstep = 2 * hstep;
    const unsigned ldsw = (unsigned)wid * 1024u;
    const int aoff = lds_byte(wr * 64 + fr, fq * 8), boff = lds_byte(wc * 32 + fr, fq * 8);
#define PG8_SA(b, h) (((b) * 2 + (h)) * HTB)
#define PG8_SB(b, h) ((4 + (b) * 2 + (h)) * HTB)
    const __amdgpu_buffer_rsrc_t rsA = __builtin_amdgcn_make_buffer_rsrc((void*)g.A, 0, 0x7FFFFFFF, 0x00027000), rsB = __builtin_amdgcn_make_buffer_rsrc((void*)g.Bt, 0, 0x7FFFFFFF, 0x00027000);
#define PG8_STAGE(bufoff, gbase, voff) do { const bool isb_ = (bufoff) >= 4 * HTB; const unsigned so_ = (unsigned)((const char*)(gbase) - (isb_ ? (const char*)g.Bt : (const char*)g.A)); \
        _Pragma("unroll") for (int _i = 0; _i < 2; ++_i) \
        __builtin_amdgcn_raw_ptr_buffer_load_lds(isb_ ? rsB : rsA, (PG8_LAS void*)(lds + (bufoff) + ldsw + _i * 8192), 16, (int)(voff)[_i], (int)so_, 0, 0); } while (0)
#define PG8_LDA(dst, b, h) do { _Pragma("unroll") for (int m = 0; m < 4; ++m) _Pragma("unroll") for (int k = 0; k < 2; ++k) dst[m][k] = *(const PG8_LAS bf16x8*)(lds + PG8_SA(b, h) + aoff + m * 2048 + k * 1024); } while (0)
#define PG8_LDB(dst, b, h) do { _Pragma("unroll") for (int n = 0; n < 2; ++n) _Pragma("unroll") for (int k = 0; k < 2; ++k) dst[n][k] = *(const PG8_LAS bf16x8*)(lds + PG8_SB(b, h) + boff + n * 2048 + k * 1024); } while (0)
#define PG8_MMA_(ai, bj, At, Bt, FZ) do { __builtin_amdgcn_s_setprio(1); _Pragma("unroll") for (int m = 0; m < 4; ++m) _Pragma("unroll") for (int n = 0; n < 2; ++n) _Pragma("unroll") for (int k = 0; k < 2; ++k) \
        acc[ai][bj][m][n] = __builtin_amdgcn_mfma_f32_16x16x32_bf16(Bt[n][k], At[m][k], ((FZ) && k == 0) ? (f32x4){0.f, 0.f, 0.f, 0.f} : acc[ai][bj][m][n], 0, 0, 0); __builtin_amdgcn_s_setprio(0); } while (0)
#define PG8_MMA(ai, bj, At, Bt) PG8_MMA_(ai, bj, At, Bt, false)
#define PG8_MMA0(ai, bj, At, Bt) do { if (SP2 && t == 0) PG8_MMA_(ai, bj, At, Bt, true); else PG8_MMA_(ai, bj, At, Bt, false); } while (0)
#define PG8_WAIT_V(n) asm volatile("s_waitcnt vmcnt(" #n ")" ::: "memory")
#define PG8_WAIT_L(n) asm volatile("s_waitcnt lgkmcnt(" #n ")" ::: "memory")
#define PG8_BAR __builtin_amdgcn_s_barrier()
#define PG8_SCHED __builtin_amdgcn_sched_barrier(0)
    Unit cur = {0, 0, 0, 0, 0}, nxt = {0, 0, 0, 0, 0}; int ui = 0;
    if (!S.next(0, cur)) return;
    if (cur.nt) nt = cur.nt;
    if constexpr (GATHER) {
        for (int u_ = 0; u_ < 16; ++u_) { Unit uu_ = {0, 0, 0, 0, 0}; if (!S.next(u_, uu_)) break; if (tid < 256) ridx[u_ * 256 + tid] = (unsigned short)g.rowidx[(size_t)uu_.pm * BM + tid]; }
        __syncthreads();
    }
    f32x4 acc[2][2][4][2];
    if constexpr (!SP2)
#pragma unroll
    for (int a = 0; a < 2; ++a)
#pragma unroll
        for (int b = 0; b < 2; ++b)
#pragma unroll
            for (int m = 0; m < 4; ++m)
#pragma unroll
                for (int n = 0; n < 2; ++n) acc[a][b][m][n] = (f32x4){0.f, 0.f, 0.f, 0.f};
    bf16x8 At[4][2], B0[2][2], B1[2][2];
    const char* cA = (const char*)g.A + (GATHER ? (size_t)0 : (size_t)cur.pm * tstep + ((cur.flags & 2) ? hstep : (size_t)0)) + (size_t)cur.kofs * kstep; const char* cB = (const char*)g.Bt + (size_t)cur.pn * tstep + (size_t)cur.kofs * kstep;
    S.a_ready(cur);
    if constexpr (SP2) {
        if (GATHER) PG8_GOFF(oc0, oc1, cur, 0);
        PG8_STAGE(PG8_SB(0, 0), cB, voffB); PG8_STAGE(PG8_SB(0, 1), cB + hstep, voffB); PG8_STAGE(PG8_SA(0, 0), cA, (GATHER ? oc0 : voffA)); PG8_STAGE(PG8_SA(0, 1), cA + hA, (GATHER ? oc1 : voffA));
        if (wr == 1) PG8_BAR;
        PG8_WAIT_V(2); PG8_BAR;
        PG8_STAGE(PG8_SB(1, 0), cB + kstep, voffB); PG8_STAGE(PG8_SA(1, 0), cA + kstep, (GATHER ? oc0 : voffA)); PG8_STAGE(PG8_SB(1, 1), cB + hstep + kstep, voffB);
        PG8_WAIT_V(6); PG8_BAR;
    } else {
        PG8_STAGE(PG8_SB(0, 0), cB, voffB); PG8_STAGE(PG8_SA(0, 0), cA, voffA); PG8_STAGE(PG8_SB(0, 1), cB + hstep, voffB); PG8_STAGE(PG8_SA(0, 1), cA + hstep, voffA);
        if (wr == 1) PG8_BAR;
        PG8_WAIT_V(4); PG8_BAR;
        PG8_STAGE(PG8_SB(1, 0), cB + kstep, voffB); PG8_STAGE(PG8_SA(1, 0), cA + kstep, voffA); PG8_STAGE(PG8_SB(1, 1), cB + hstep + kstep, voffB);
        PG8_WAIT_V(6); PG8_BAR;
    }
    for (;;) {
        nxt = (Unit){0, 0, 0, 0, 0};
        const bool has_next = S.next(ui + 1, nxt); const bool full_m = !(cur.flags & 1);
        const char* nA = has_next ? (const char*)g.A + (GATHER ? (size_t)0 : (size_t)nxt.pm * tstep + ((nxt.flags & 2) ? hstep : (size_t)0)) + (size_t)nxt.kofs * kstep : cA; const char* nB = has_next ? (const char*)g.Bt + (size_t)nxt.pn * tstep + (size_t)nxt.kofs * kstep : cB;
        for (int t = 0; t < nt; t += 2) {
            const bool last = (t == nt - 2);
            const char* a1 = cA + (size_t)(t + 1) * kstep;
            const char* a2 = last ? nA : cA + (size_t)(t + 2) * kstep; const char* b2 = last ? nB : cB + (size_t)(t + 2) * kstep;
            const char* a3 = a2 + kstep; const char* b3 = b2 + kstep;
            if (last && has_next) S.a_ready(nxt);
            if (GATHER) { if (last && has_next) PG8_GOFF(on0, on1, nxt, ui + 1); }
            unsigned s0[2], s1[2];
#pragma unroll
            for (int _i = 0; _i < 2; ++_i) { s0[_i] = GATHER ? ((last && has_next) ? on0[_i] : oc0[_i]) : voffA[_i]; s1[_i] = GATHER ? ((last && has_next) ? on1[_i] : oc1[_i]) : voffA[_i]; }
            if constexpr (SP2) {
            PG8_LDB(B0, 0, 0); PG8_LDB(B1, 0, 1); PG8_SCHED; PG8_LDA(At, 0, 0); PG8_STAGE(PG8_SA(1, 1), a1 + hA, (GATHER ? oc1 : voffA));
            PG8_WAIT_V(8); PG8_WAIT_L(0); PG8_BAR; PG8_MMA0(0, 0, At, B0); PG8_MMA0(0, 1, At, B1); PG8_BAR; PG8_SCHED;
            PG8_LDA(At, 0, 1); PG8_STAGE(PG8_SB(0, 0), b2, voffB); PG8_STAGE(PG8_SB(0, 1), b2 + hstep, voffB); PG8_STAGE(PG8_SA(0, 0), a2, s0);
            PG8_WAIT_V(8); PG8_WAIT_L(0); PG8_BAR; if (full_m) { PG8_MMA0(1, 0, At, B0); PG8_MMA0(1, 1, At, B1); } PG8_BAR; PG8_SCHED;
            PG8_LDB(B0, 1, 0); PG8_LDB(B1, 1, 1); PG8_SCHED; PG8_LDA(At, 1, 0); PG8_STAGE(PG8_SA(0, 1), a2 + hA, s1);
            PG8_WAIT_V(8); PG8_WAIT_L(0); PG8_BAR; PG8_MMA(0, 0, At, B0); PG8_MMA(0, 1, At, B1); PG8_BAR; PG8_SCHED;
            PG8_LDA(At, 1, 1); PG8_STAGE(PG8_SB(1, 0), b3, voffB); PG8_STAGE(PG8_SB(1, 1), b3 + hstep, voffB); PG8_STAGE(PG8_SA(1, 0), a3, s0);
            PG8_WAIT_V(8); PG8_WAIT_L(0); PG8_BAR; if (full_m) { PG8_MMA(1, 0, At, B0); PG8_MMA(1, 1, At, B1); } PG8_BAR; PG8_SCHED;
            } else {
            PG8_LDB(B0, 0, 0); PG8_SCHED; PG8_LDA(At, 0, 0); PG8_STAGE(PG8_SA(1, 1), a1 + hstep, voffA);
            PG8_WAIT_L(8); PG8_BAR; PG8_WAIT_L(0); PG8_MMA(0, 0, At, B0); PG8_BAR; PG8_SCHED;
            PG8_LDB(B1, 0, 1); PG8_STAGE(PG8_SB(0, 0), b2, voffB);
            PG8_BAR; PG8_WAIT_L(0); PG8_MMA(0, 1, At, B1); PG8_BAR;
            PG8_LDA(At, 0, 1); PG8_STAGE(PG8_SA(0, 0), a2, voffA);
            PG8_BAR; PG8_WAIT_L(0); PG8_MMA(1, 0, At, B0); PG8_BAR; PG8_SCHED;
            PG8_STAGE(PG8_SB(0, 1), b2 + hstep, voffB);
            PG8_WAIT_V(6); PG8_BAR; PG8_MMA(1, 1, At, B1); PG8_BAR;
            PG8_LDB(B0, 1, 0); PG8_SCHED; PG8_LDA(At, 1, 0); PG8_STAGE(PG8_SA(0, 1), a2 + hstep, voffA);
            PG8_WAIT_L(8); PG8_BAR; PG8_WAIT_L(0); PG8_MMA(0, 0, At, B0); PG8_BAR; PG8_SCHED;
            PG8_LDB(B1, 1, 1); PG8_STAGE(PG8_SB(1, 0), b3, voffB);
            PG8_BAR; PG8_WAIT_L(0); PG8_MMA(0, 1, At, B1); PG8_BAR;
            PG8_LDA(At, 1, 1); PG8_STAGE(PG8_SA(1, 0), a3, voffA);
            PG8_BAR; PG8_WAIT_L(0); PG8_MMA(1, 0, At, B0); PG8_BAR; PG8_SCHED;
            PG8_STAGE(PG8_SB(1, 1), b3 + hstep, voffB);
            PG8_WAIT_V(6); PG8_BAR; PG8_MMA(1, 1, At, B1); PG8_BAR;
            }
        }
        if constexpr (ALIGN_EPI) { if (wr == 0) PG8_BAR; }
        if constexpr (!Epi::AFTER_DRAIN) { E(acc, cur, wr, wc, fr, fq); S.done(cur); }
        if (!has_next) break;
        if constexpr (!SP2)
#pragma unroll
        for (int a = 0; a < 2; ++a)
#pragma unroll
            for (int b = 0; b < 2; ++b)
#pragma unroll
                for (int m = 0; m < 4; ++m)
#pragma unroll
                    for (int n = 0; n < 2; ++n) acc[a][b][m][n] = (f32x4){0.f, 0.f, 0.f, 0.f};
        cur = nxt; cA = nA; cB = nB; ++ui; nt = cur.nt ? cur.nt : K / BK;
        if (GATHER) {
#pragma unroll
            for (int _i = 0; _i < 2; ++_i) { oc0[_i] = on0[_i]; oc1[_i] = on1[_i]; } }
        if constexpr (ALIGN_EPI) { if (wr == 1) PG8_BAR; }
    }
    PG8_WAIT_V(0);
    if constexpr (!ALIGN_EPI) { if (wr == 0) PG8_BAR; }
    PG8_BAR;
    if constexpr (Epi::AFTER_DRAIN) { E.fused(acc, cur, wr, wc, fr, fq, lds, wid, lane); S.done(cur); }
#undef PG8_GOFF
#undef PG8_SA
#undef PG8_SB
#undef PG8_STAGE
#undef PG8_LDA
#undef PG8_LDB
#undef PG8_MMA
#undef PG8_MMA_
#undef PG8_MMA0
#undef PG8_WAIT_V
#undef PG8_WAIT_L
#undef PG8_BAR
#undef PG8_SCHED
}
}
#define GAS __attribute__((address_space(1)))
constexpr int DM = 1024, NB = 2, TL = 8192, TCX = 256;
constexpr int RL = NB * TL, RC = NB * TCX, RT = RL + RC;
constexpr int NH = 8;
constexpr int NE = 16, FE = 2816, CAPL = 1024, CAPC = 32, MROWS = 2304, MTE = 9;
constexpr int NCH = 132;
constexpr float EPS = 1e-6f;
constexpr int NWAVES = 8, NPH = 21;
constexpr float LAM_INIT = 0.35550906759f;
constexpr float QSCALE = 0.125f * 1.4426950408889634f;

typedef unsigned short bf16;
typedef short bf16x8 __attribute__((ext_vector_type(8)));
typedef short s16x4 __attribute__((ext_vector_type(4)));
typedef float f32x4 __attribute__((ext_vector_type(4)));
typedef float f32x2 __attribute__((ext_vector_type(2)));
typedef float f32x16 __attribute__((ext_vector_type(16)));
typedef unsigned u32x4 __attribute__((ext_vector_type(4)));
typedef unsigned u32x2 __attribute__((ext_vector_type(2)));
#define LAS __attribute__((address_space(3)))

constexpr size_t MiB = 1u << 20;
constexpr size_t WS_CTL = 0, CTL_ZERO_BYTES = 1 * MiB;
constexpr size_t WS_TAB = 1 * MiB;
constexpr size_t TAB_MOD = 0, TAB_LB = 163840, TAB_LAM = 172032, TAB_ROPE = 176128;
constexpr size_t WS_WHIN = 2 * MiB, WS_WHOUT = 12 * MiB, WS_WDIN = 14 * MiB, WS_WDOUT = 20 * MiB;
constexpr size_t WS_AFF = 22 * MiB, WS_SLOT = 24 * MiB, WS_IDX = 26 * MiB;
constexpr size_t WS_XA = 28 * MiB, WS_XB = 94 * MiB, WS_H = 160 * MiB, WS_OMIX = 193 * MiB;
constexpr size_t WS_WGU0 = 226 * MiB, WS_WDN0 = 402 * MiB, WS_WGU1 = 490 * MiB, WS_WDN1 = 666 * MiB;
constexpr size_t WS_ARENA = 754 * MiB;
constexpr size_t WS_Q = WS_ARENA, WS_LFF = WS_Q + 33 * MiB, WS_LFB = WS_LFF + 66 * MiB, WS_V = WS_LFB + 66 * MiB, WS_SG = WS_V + 33 * MiB;
constexpr size_t WS_P = WS_SG + 33 * MiB, WS_SS = WS_P + 264 * MiB, WS_DD = WS_SS + 132 * MiB, WS_HG_END = WS_DD + 3 * MiB;
constexpr size_t WS_XS = WS_ARENA, WS_ACT = WS_XS + 72 * MiB, WS_Y = WS_ACT + 198 * MiB, WS_Y2 = WS_Y + 72 * MiB, WS_MOE_END = WS_Y2 + 72 * MiB;
constexpr size_t WS_QA = WS_ARENA, WS_KA = WS_QA + 32 * MiB, WS_VA = WS_KA + 33 * MiB, WS_ON = WS_VA + 33 * MiB, WS_AT_END = WS_ON + 128 * MiB;
constexpr size_t WS_END = WS_HG_END;
static_assert(WS_HG_END >= WS_MOE_END && WS_HG_END >= WS_AT_END, "arena");
static_assert((size_t)RT * DM * 4 == 66 * MiB && (size_t)RT * DM * 2 == 33 * MiB, "sizes");
static_assert((size_t)NE * 5632 * 1024 * 2 == 176 * MiB && (size_t)NE * 1024 * FE * 2 == 88 * MiB, "sizes");
static_assert((size_t)NE * MROWS * FE * 2 == 198 * MiB && (size_t)NE * MROWS * DM * 2 == 72 * MiB, "sizes");
static_assert((size_t)32 * NCH * 128 * 128 * 4 == 264 * MiB, "sizes");
constexpr int CW_BAR = 4096, CW_ERR = 16384, CW_KMX = 20480, CW_QCTR = 21504, CW_DONE = 24576;

constexpr int LDS_BYTES = 147456, MISC_OFF = 140000;

__device__ __forceinline__ float bf2f(unsigned short b) { return __uint_as_float(((unsigned)b) << 16); }
__device__ __forceinline__ unsigned f2bf(float f) { unsigned u = __float_as_uint(f); return (u + 0x7fffu + ((u >> 16) & 1u)) >> 16; }
typedef float f32x2c_t __attribute__((ext_vector_type(2))); typedef __bf16 bf16x2c_t __attribute__((ext_vector_type(2)));
__device__ __forceinline__ unsigned cvtpk_mf(float lo, float hi) { const f32x2c_t v = {lo, hi}; const bf16x2c_t c = __builtin_convertvector(v, bf16x2c_t); return __builtin_bit_cast(unsigned, c); }
__device__ __forceinline__ float wave_sum(float v) {
#define WS_DPP(x, ctrl, rmask) __builtin_bit_cast(float, __builtin_amdgcn_update_dpp(0, __builtin_bit_cast(int, x), ctrl, rmask, 0xf, false))
    v += WS_DPP(v, 0xB1, 0xf);
    v += WS_DPP(v, 0x4E, 0xf);
    v += WS_DPP(v, 0x141, 0xf);
    v += WS_DPP(v, 0x140, 0xf);
    v += WS_DPP(v, 0x142, 0xa);
    v += WS_DPP(v, 0x143, 0xc);
#undef WS_DPP
    return __builtin_bit_cast(float, __builtin_amdgcn_readlane(__builtin_bit_cast(int, v), 63));
}
__device__ __forceinline__ float silu_f(float x) { return x / (1.f + __expf(-x)); }
__device__ __forceinline__ int crow(int r, int hi) { return (r & 3) + 8 * (r >> 2) + 4 * hi; }
#define KSWZ(row, colB) ((row) * 256 + ((colB) ^ (((row) & 7) << 4)))
#define KSWZ64(row, colB) ((row) * 128 + ((colB) ^ ((((row) >> 1) & 7) << 4)))
#define SBAR() __builtin_amdgcn_sched_barrier(0)
#define LDS_WAIT() asm volatile("s_waitcnt lgkmcnt(0)" ::: "memory")
#define VM_WAIT() asm volatile("s_waitcnt vmcnt(0)" ::: "memory")

__device__ __forceinline__ int v_st(int k, int c) { const int kk = (k & ~0xC) | ((k & 4) << 1) | ((k & 8) >> 1); return ((kk >> 3) * 4 + (c >> 5)) * 512 + ((kk & 7) * 32 + (c & 31)) * 2; }
__device__ __forceinline__ int v_rd_base(int lane) { return ((lane & 3) << 3) | (((lane >> 2) & 3) << 6) | (((lane >> 4) & 1) << 5) | (((lane >> 5) & 1) << 8); }
constexpr int v_rd_off(int d0, int ks, int half) { return d0 * 512 + ks * 4096 + half * 2048; }
template <int OFF> __device__ __forceinline__ s16x4 tr_read(int vb) {
    s16x4 r; asm volatile("ds_read_b64_tr_b16 %0, %1 offset:%2" : "=&v"(r) : "v"(vb), "i"(OFF) : "memory"); return r;
}
__device__ __forceinline__ void pvb(f32x16& od, int vb, bf16x8 pa0, bf16x8 pa1, bf16x8 pa2, bf16x8 pa3) {
    const s16x4 l0 = tr_read<v_rd_off(0, 0, 0)>(vb), h0 = tr_read<v_rd_off(0, 0, 1)>(vb), l1 = tr_read<v_rd_off(0, 1, 0)>(vb), h1 = tr_read<v_rd_off(0, 1, 1)>(vb);
    const s16x4 l2 = tr_read<v_rd_off(0, 2, 0)>(vb), h2 = tr_read<v_rd_off(0, 2, 1)>(vb), l3 = tr_read<v_rd_off(0, 3, 0)>(vb), h3 = tr_read<v_rd_off(0, 3, 1)>(vb);
    asm volatile("s_waitcnt lgkmcnt(0)" ::: "memory"); SBAR();
#define PKV(L, H) (bf16x8){L[0], L[1], L[2], L[3], H[0], H[1], H[2], H[3]}
    od = __builtin_amdgcn_mfma_f32_32x32x16_bf16(pa0, PKV(l0, h0), od, 0, 0, 0);
    od = __builtin_amdgcn_mfma_f32_32x32x16_bf16(pa1, PKV(l1, h1), od, 0, 0, 0);
    od = __builtin_amdgcn_mfma_f32_32x32x16_bf16(pa2, PKV(l2, h2), od, 0, 0, 0);
    od = __builtin_amdgcn_mfma_f32_32x32x16_bf16(pa3, PKV(l3, h3), od, 0, 0, 0);
#undef PKV
}
__device__ __forceinline__ unsigned cvtpk(float lo, float hi) { unsigned r; asm volatile("v_cvt_pk_bf16_f32 %0, %1, %2" : "=v"(r) : "v"(lo), "v"(hi)); return r; }
#define PK4(P, BASE, OUT) do { unsigned a0_ = cvtpk_mf(P[BASE + 0], P[BASE + 1]), a1_ = cvtpk_mf(P[BASE + 2], P[BASE + 3]);   \
    unsigned b0_ = cvtpk_mf(P[BASE + 4], P[BASE + 5]), b1_ = cvtpk_mf(P[BASE + 6], P[BASE + 7]);                              \
    auto r0_ = __builtin_amdgcn_permlane32_swap(a0_, b0_, false, false); auto r1_ = __builtin_amdgcn_permlane32_swap(a1_, b1_, false, false); \
    u32x4 w_ = {r0_[0], r1_[0], r0_[1], r1_[1]}; OUT = *reinterpret_cast<bf16x8*>(&w_); } while (0)
#define PK4A(P, BASE, OUT) do { unsigned a0_ = cvtpk(P[BASE + 0], P[BASE + 1]), a1_ = cvtpk(P[BASE + 2], P[BASE + 3]);   \
    unsigned b0_ = cvtpk(P[BASE + 4], P[BASE + 5]), b1_ = cvtpk(P[BASE + 6], P[BASE + 7]);                              \
    auto r0_ = __builtin_amdgcn_permlane32_swap(a0_, b0_, false, false); auto r1_ = __builtin_amdgcn_permlane32_swap(a1_, b1_, false, false); \
    u32x4 w_ = {r0_[0], r1_[0], r0_[1], r1_[1]}; OUT = *reinterpret_cast<bf16x8*>(&w_); } while (0)

struct Args { const float* in[21]; float* out; unsigned char* ws; int ph_lo, ph_hi; };
#define XB_TMO      128
#define XB_XCNT(j)  (256  + 64 * (j))
#define XB_XSUB(j)  (1280 + 64 * (j))
#define XB_XGEN(j)  (2304 + 64 * (j))
#define XB_TOP      3328
#define XB_TOPGEN   3392
#define XCD_BAR_WORDS 3456
#define XB_SPIN_CAP (1u << 18)

__device__ __forceinline__ unsigned xb_ld(unsigned* p)              { return __hip_atomic_load(p, __ATOMIC_RELAXED, __HIP_MEMORY_SCOPE_AGENT); }
__device__ __forceinline__ unsigned xb_add(unsigned* p, unsigned v) { return __hip_atomic_fetch_add(p, v, __ATOMIC_RELAXED, __HIP_MEMORY_SCOPE_AGENT); }
__device__ __forceinline__ unsigned xb_xcc_id() { return (unsigned)__builtin_amdgcn_s_getreg((3 << 11) | 20) & 0xFu; }
#define XB_SPIN(cond, bar) do { unsigned _sp = 0; while (cond) { __builtin_amdgcn_s_sleep(1); \
    if ((++_sp & 255u) == 0u) { if (xb_ld(&(bar)[XB_TMO])) break; if (_sp > XB_SPIN_CAP) { atomicAdd(&(bar)[XB_TMO], 1u); break; } } } } while (0)

struct XcdBarrier {
    unsigned* bar; unsigned x;
    volatile LAS unsigned* st;
};

__device__ __forceinline__ XcdBarrier xcd_barrier_post(unsigned* bar, volatile LAS unsigned* st) {
    XcdBarrier b; b.bar = bar; b.x = xb_xcc_id(); b.st = st;
    if (threadIdx.x == 0) (void)xb_add(&bar[XB_XCNT(b.x)], 1u);
    return b;
}
__device__ __forceinline__ void xcd_barrier_complete(unsigned* bar, unsigned x, unsigned& nloc, unsigned& nx) {
    const unsigned G = gridDim.x * gridDim.y * gridDim.z;
    unsigned sum, cnt, mine, sp = 0u;
    for (;;) {
        sum = 0u; cnt = 0u; mine = 0u;
#pragma unroll
        for (unsigned j = 0; j < 16; ++j) { const unsigned c = xb_ld(&bar[XB_XCNT(j)]); sum += c; cnt += (c > 0u) ? 1u : 0u; mine = (j == x) ? c : mine; }
        if (sum == G) break;
        __builtin_amdgcn_s_sleep(1);
        if ((++sp & 255u) == 0u) { if (xb_ld(&bar[XB_TMO])) break; if (sp > XB_SPIN_CAP) { atomicAdd(&bar[XB_TMO], 1u); break; } }
    }
    nloc = mine > 0u ? mine : 1u; nx = cnt > 0u ? cnt : 1u;
}

__device__ __forceinline__ void xcd_barrier(const XcdBarrier& b) {
    asm volatile("s_waitcnt vmcnt(0)" ::: "memory");
    __syncthreads();
    if (threadIdx.x == 0) {
        unsigned* bar = b.bar;
        __builtin_amdgcn_s_waitcnt(0);
        unsigned nloc = b.st[0], nx = b.st[1];
        if (nloc == 0u) { xcd_barrier_complete(bar, b.x, nloc, nx); b.st[0] = nloc; b.st[1] = nx; }
        const unsigned old = xb_add(&bar[XB_XSUB(b.x)], 1u);
        const unsigned gen = old / nloc;
        if (old + 1u == (gen + 1u) * nloc) {
            __builtin_amdgcn_fence(__ATOMIC_RELEASE, "agent");
            asm volatile("s_waitcnt vmcnt(0)" ::: "memory");
            const unsigned og = xb_add(&bar[XB_TOP], 1u);
            const unsigned tg = og / nx;
            if (og + 1u == (tg + 1u) * nx) xb_add(&bar[XB_TOPGEN], 1u);
            else XB_SPIN(xb_ld(&bar[XB_TOPGEN]) == tg, bar);
            __builtin_amdgcn_fence(__ATOMIC_ACQUIRE, "agent");
            xb_add(&bar[XB_XGEN(b.x)], 1u);
            asm volatile("s_waitcnt vmcnt(0)" ::: "memory");
        } else {
            XB_SPIN(xb_ld(&bar[XB_XGEN(b.x)]) == gen, bar);
            __builtin_amdgcn_fence(__ATOMIC_ACQUIRE, "agent");
            asm volatile("s_waitcnt vmcnt(0)" ::: "memory");
        }
    }
    __syncthreads();
}
namespace pg8 {
struct TailOrder {
    StaticOrder S0; int nmain, ntail, tm0, tn0, tnn, G, c;
    __device__ __forceinline__ void init(int nM, int nN, int G_, int c_, int tm0_, int tn0_, int tmm, int tnn_) { S0.init(nM * BM, nN * BM, G_, c_); nmain = nM * nN; tm0 = tm0_; tn0 = tn0_; tnn = tnn_; ntail = tmm * tnn_ * 2; G = G_; c = c_; }
    __device__ __forceinline__ bool next(int i, Unit& u) const {
        const long L = (long)i * G + c; if (L >= nmain + ntail) return false;
        const bool tl = L >= nmain;
        Unit m = {0, 0, 0, 0, 0}; (void)S0.next(tl ? 0 : i, m);
        const int idx = tl ? (int)(L - nmain) : 0, hf = idx & 1, t = idx >> 1;
        const int pm = tl ? tm0 + t / tnn : m.pm, pn = tl ? tn0 + t % tnn : m.pn, fl = tl ? (1 | (hf << 1)) : 0;
        u.pm = pm; u.pn = pn; u.nt = 0; u.kofs = 0; u.flags = fl;
        return true;
    }
    __device__ __forceinline__ void a_ready(const Unit&) const {}
    __device__ __forceinline__ void done(const Unit&) const {}
};
struct GroupedOrder {
    int G, c, nNt, nmain, ntail, ks, knt;
    __device__ __forceinline__ void init(int nNt_, int G_, int c_, bool tail, int ks_, int ktiles) { nNt = nNt_; G = G_; c = c_; nmain = NE * 8 * nNt_; ks = ks_; knt = ktiles / ks_; ntail = tail ? NE * nNt_ * ks_ : 0; }
    __device__ __forceinline__ bool next(int i, Unit& u) const {
        const long L = (long)i * G + c; if (L >= nmain + ntail) return false;
        const bool tl = L >= nmain;
        int wgid = (int)L; { const int q = nmain / NXCD, r = nmain % NXCD, xcd = wgid % NXCD, off = wgid / NXCD; wgid = (xcd < r ? xcd * (q + 1) : r * (q + 1) + (xcd - r) * q) + off; }
        const int nig = 8 * nNt, e_m = wgid / nig, w = wgid % nig;
        const int idx = (int)(L - nmain), sl = idx % ks, t = idx / ks, e_t = t / nNt;
        const int pm = tl ? e_t * MTE + 8 : e_m * MTE + (w % 8), pn = tl ? e_t * nNt + t % nNt : e_m * nNt + (w / 8);
        const int unt = (tl && ks > 1) ? knt : 0, uko = (tl && ks > 1) ? sl * knt : 0, ufl = tl ? 1 : 0;
        u.pm = pm; u.pn = pn; u.nt = unt; u.kofs = uko; u.flags = ufl;
        return true;
    }
    __device__ __forceinline__ void a_ready(const Unit&) const {}
    __device__ __forceinline__ void done(const Unit&) const {}
};

__device__ __forceinline__ u32x4 pack8(const f32x4 a, const f32x4 b) { u32x4 w; w.x = cvt_pk_bf16(a[0], a[1]); w.y = cvt_pk_bf16(a[2], a[3]); w.z = cvt_pk_bf16(b[0], b[1]); w.w = cvt_pk_bf16(b[2], b[3]); return w; }
__device__ __forceinline__ f32x4 silu4(const f32x4 x) { f32x4 r; for (int j = 0; j < 4; ++j) r[j] = x[j] * __builtin_amdgcn_rcpf(1.f + __expf(-x[j])); return r; }

struct EpiHin {
    static constexpr bool PERM = true, AFTER_DRAIN = false;
    bf16_t* Q; bf16_t* LFF; bf16_t* LFB; bf16_t* V; bf16_t* SG; const float* LB;
    __device__ __forceinline__ void operator()(const f32x4 (&acc)[2][2][4][2], const Unit& u, int wr, int wc, int fr, int fq) const {
        const int sec = u.pn >> 2, colt = (u.pn & 3) * BM, row0 = u.pm * BM + ((u.flags & 2) ? HALF : 0) + wr * 64 + fr;
#pragma unroll
        for (int ai = 0; ai < 2; ++ai) { if (ai == 1 && (u.flags & 1)) continue;
#pragma unroll
            for (int m = 0; m < 4; ++m) { const size_t roff = (size_t)(row0 + ai * HALF + m * 16) * 1024;
#pragma unroll
                for (int bj = 0; bj < 2; ++bj) { const int col0 = colt + bj * HALF + wc * 32 + 8 * fq; const f32x4 v0 = acc[ai][bj][m][0], v1 = acc[ai][bj][m][1];
                    if (sec == 0)      *(u32x4*)(Q + roff + col0) = pack8(silu4(v0), silu4(v1));
                    else if (sec == 4) *(u32x4*)(SG + roff + col0) = pack8(silu4(v0), silu4(v1));
                    else if (sec == 3) *(u32x4*)(V + roff + col0) = pack8(v0, v1);
                    else { const f32x4 l0 = *(const f32x4*)(LB + col0), l1 = *(const f32x4*)(LB + col0 + 4); f32x4 o0, o1;
#pragma unroll
                        for (int j = 0; j < 4; ++j) { o0[j] = __builtin_amdgcn_logf(l0[j] + (1.f - l0[j]) * __builtin_amdgcn_rcpf(1.f + __expf(-v0[j]))); o1[j] = __builtin_amdgcn_logf(l1[j] + (1.f - l1[j]) * __builtin_amdgcn_rcpf(1.f + __expf(-v1[j]))); }
                        *(u32x4*)((sec == 1 ? LFF : LFB) + roff + col0) = pack8(o0, o1); } } } }
    }
};
struct EpiResid {
    static constexpr bool PERM = false, AFTER_DRAIN = false;
    const float* xlat; const float* xctx; const float* gate; float* out;
    __device__ __forceinline__ void operator()(const f32x4 (&acc)[2][2][4][2], const Unit& u, int wr, int wc, int fr, int fq) const {
        const int row0 = u.pm * BM + ((u.flags & 2) ? HALF : 0) + wr * 64 + fr, col0 = u.pn * BM + wc * 32 + 4 * fq;
#pragma unroll
        for (int ai = 0; ai < 2; ++ai) { if (ai == 1 && (u.flags & 1)) continue;
#pragma unroll
            for (int m = 0; m < 4; ++m) { const int row = row0 + ai * HALF + m * 16; const int rc = row < TL ? 0 : (row < RL ? 1 : 2);
                const float* src = row < RL ? xlat + (size_t)row * 1024 : xctx + (size_t)(row - RL) * 1024; const float* gp = gate + rc * 6144; float* dst = out + (size_t)row * 1024;
#pragma unroll
                for (int bj = 0; bj < 2; ++bj)
#pragma unroll
                    for (int n = 0; n < 2; ++n) { const int c = col0 + bj * HALF + n * 16; const f32x4 x = *(const f32x4*)(src + c), g = *(const f32x4*)(gp + c); *(f32x4*)(dst + c) = x + g * acc[ai][bj][m][n]; } } }
    }
};
__device__ __forceinline__ f32x4 silu4_l2(const f32x4 x) { f32x4 r; for (int j = 0; j < 4; ++j) r[j] = x[j] * __builtin_amdgcn_rcpf(1.f + __builtin_amdgcn_exp2f(-x[j])); return r; }
struct EpiMoe1 {
    static constexpr bool PERM = true, AFTER_DRAIN = false;
    bf16_t* ACT;
    __device__ __forceinline__ void operator()(const f32x4 (&acc)[2][2][4][2], const Unit& u, int wr, int wc, int fr, int fq) const {
        const int nt = u.pn % 22, row0 = u.pm * BM + wr * 64 + fr, col0 = nt * 128 + wc * 32 + 8 * fq;
#pragma unroll
        for (int ai = 0; ai < 2; ++ai) { if (ai == 1 && (u.flags & 1)) continue;
#pragma unroll
            for (int m = 0; m < 4; ++m) { const size_t roff = (size_t)(row0 + ai * HALF + m * 16) * FE;
                const f32x4 a0 = silu4_l2(acc[ai][0][m][0]) * acc[ai][1][m][0], a1 = silu4_l2(acc[ai][0][m][1]) * acc[ai][1][m][1];
                *(u32x4*)(ACT + roff + col0) = pack8(a0, a1); } }
    }
};
struct EpiMoe2 {
    static constexpr bool PERM = true, AFTER_DRAIN = false;
    bf16_t* Y; bf16_t* Y2;
    __device__ __forceinline__ void operator()(const f32x4 (&acc)[2][2][4][2], const Unit& u, int wr, int wc, int fr, int fq) const {
        const int nt = u.pn & 3, row0 = u.pm * BM + wr * 64 + fr, col0 = nt * BM + wc * 32 + 8 * fq; bf16_t* dst = u.kofs ? Y2 : Y;
#pragma unroll
        for (int ai = 0; ai < 2; ++ai) { if (ai == 1 && (u.flags & 1)) continue;
#pragma unroll
            for (int m = 0; m < 4; ++m) { const size_t roff = (size_t)(row0 + ai * HALF + m * 16) * 1024;
#pragma unroll
                for (int bj = 0; bj < 2; ++bj) *(u32x4*)(dst + roff + col0 + bj * HALF) = pack8(acc[ai][bj][m][0], acc[ai][bj][m][1]); } }
    }
};
struct EpiDin {
    static constexpr bool PERM = true, AFTER_DRAIN = false;
    bf16_t* QA; bf16_t* KA; bf16_t* VA; const float* rope;
    unsigned* KMX;
    __device__ __forceinline__ void operator()(const f32x4 (&acc)[2][2][4][2], const Unit& u, int wr, int wc, int fr, int fq) const {
        const int sec = u.pn >> 2, colt = (u.pn & 3) * BM, row0 = u.pm * BM + ((u.flags & 2) ? HALF : 0) + wr * 64 + fr;
        float kmx[2] = {0.f, 0.f};
#pragma unroll
        for (int ai = 0; ai < 2; ++ai) { if (ai == 1 && (u.flags & 1)) continue;
#pragma unroll
            for (int m = 0; m < 4; ++m) { const int row = row0 + ai * HALF + m * 16; const size_t roff = (size_t)row * 1024; const int t = row & (TL - 1), rp = t >> 6, cp = t & 63;
#pragma unroll
                for (int bj = 0; bj < 2; ++bj) { const int col0 = colt + bj * HALF + wc * 32 + 8 * fq; f32x4 v0 = acc[ai][bj][m][0], v1 = acc[ai][bj][m][1];
                    if (sec == 2) { *(u32x4*)(VA + roff + col0) = pack8(v0, v1); continue; }
                    if (row < RL) { const int i0 = (col0 & 63) >> 1; const float* tb = (i0 < 16) ? rope + (size_t)(rp * 16 + i0) * 2 : rope + (size_t)((128 + cp) * 16 + (i0 - 16)) * 2;
                        const f32x4 cs0 = *(const f32x4*)tb, cs1 = *(const f32x4*)(tb + 4);
                        f32x4 o0, o1;
                        o0[0] = v0[0] * cs0[0] - v0[1] * cs0[1]; o0[1] = v0[1] * cs0[0] + v0[0] * cs0[1];
                        o0[2] = v0[2] * cs0[2] - v0[3] * cs0[3]; o0[3] = v0[3] * cs0[2] + v0[2] * cs0[3];
                        o1[0] = v1[0] * cs1[0] - v1[1] * cs1[1]; o1[1] = v1[1] * cs1[0] + v1[0] * cs1[1];
                        o1[2] = v1[2] * cs1[2] - v1[3] * cs1[3]; o1[3] = v1[3] * cs1[2] + v1[2] * cs1[3];
                        v0 = o0; v1 = o1; }
                    if (sec == 0) { v0 = v0 * QSCALE; v1 = v1 * QSCALE; *(u32x4*)(QA + roff + col0) = pack8(v0, v1); }
                    else { *(u32x4*)(KA + roff + col0) = pack8(v0, v1);
                        float s = (v0[0] * v0[0] + v0[1] * v0[1]) + (v0[2] * v0[2] + v0[3] * v0[3]) + (v1[0] * v1[0] + v1[1] * v1[1]) + (v1[2] * v1[2] + v1[3] * v1[3]);
                        s += __shfl_xor(s, 16); s += __shfl_xor(s, 32); kmx[bj] = fmaxf(kmx[bj], s); } } } }
        if (sec == 1) {
#pragma unroll
            for (int bj = 0; bj < 2; ++bj) { float s = kmx[bj]; s = fmaxf(s, __shfl_xor(s, 1)); s = fmaxf(s, __shfl_xor(s, 2)); s = fmaxf(s, __shfl_xor(s, 4)); s = fmaxf(s, __shfl_xor(s, 8));
                if (fr == 0 && fq == 0) atomicMax(KMX + (u.pm >= 64 ? u.pm - 64 : (u.pm >> 5)) * 32 + ((colt + bj * HALF + wc * 32) >> 5), __float_as_uint(s)); } }
    }
};
}
template <int MODE> __device__ __forceinline__ int tr_outrow(int row_off, int n) {
    if (MODE == 1) return row_off + (n >> 7) * 256 + (n & 127);
    if (MODE == 2) { if (n < 2048) { const int g = n >> 6, i = n & 63; return row_off + 64 * g + ((i & 31) << 1) + (i >> 5); } return row_off + n; }
    return row_off + n;
}
template <int MODE> __device__ __forceinline__ void tr_item(const float* __restrict__ W, int K, int N, bf16* __restrict__ WT, int row_off, LAS float* scr, int item, int lane) {
    const int nblk = N / 32, kb = item / nblk, nb = item % nblk, k0 = 64 * kb, n0 = 32 * nb;
#pragma unroll 8
    for (int i = 0; i < 32; ++i) { const int kk = 2 * i + (lane >> 5); scr[kk * 33 + (lane & 31)] = W[(size_t)(k0 + kk) * N + n0 + (lane & 31)]; }
    LDS_WAIT(); asm volatile("" ::: "memory");
    const int c = lane & 7;
#pragma unroll
    for (int j = 0; j < 4; ++j) { const int n = (lane >> 3) + 8 * j; const LAS float* s = scr + (8 * c) * 33 + n;
        u32x4 o; o.x = cvtpk(s[0 * 33], s[1 * 33]); o.y = cvtpk(s[2 * 33], s[3 * 33]); o.z = cvtpk(s[4 * 33], s[5 * 33]); o.w = cvtpk(s[6 * 33], s[7 * 33]);
        *(u32x4*)(WT + (size_t)tr_outrow<MODE>(row_off, n0 + n) * K + k0 + 8 * c) = o; }
    LDS_WAIT(); asm volatile("" ::: "memory");
}
__device__ __forceinline__ void p0_prologue(const Args& a, LAS unsigned char* lds, int vcu, int G) {
    const int tid = threadIdx.x, lane = tid & 63, wave = __builtin_amdgcn_readfirstlane(tid >> 6);
    unsigned char* ws = a.ws;
    float* TAB = (float*)(ws + WS_TAB);
    for (int task = vcu; task < 51; task += G) {
        if (task < 48) {
            LAS float* sv = (LAS float*)lds;
            LAS float* red = (LAS float*)(lds + 12288);
            const int layer = task / 24, cg = task % 24;
            for (int idx = tid; idx < 3072; idx += 512) { const int j = idx >> 10, k = idx & 1023; const float x = j < 2 ? a.in[1][j * 1024 + k] : a.in[3][k]; sv[idx] = x / (1.f + __expf(-x)); }
            __syncthreads();
            const float* W = a.in[4] + (size_t)layer * 1024 * 6144 + cg * 256 + 4 * lane;
            f32x4 a0 = {0.f, 0.f, 0.f, 0.f}, a1 = a0, a2 = a0;
#pragma unroll 8
            for (int kk = 0; kk < 128; ++kk) { const int k = wave * 128 + kk; const f32x4 w = *(const f32x4*)(W + (size_t)k * 6144);
                a0 += w * sv[k]; a1 += w * sv[1024 + k]; a2 += w * sv[2048 + k]; }
            *(LAS f32x4*)(red + (wave * 3 + 0) * 256 + 4 * lane) = a0; *(LAS f32x4*)(red + (wave * 3 + 1) * 256 + 4 * lane) = a1; *(LAS f32x4*)(red + (wave * 3 + 2) * 256 + 4 * lane) = a2;
            __syncthreads();
            for (int idx = tid; idx < 768; idx += 512) { const int j = idx >> 8, cc = idx & 255; float s = a.in[5][layer * 6144 + cg * 256 + cc];
#pragma unroll
                for (int w = 0; w < 8; ++w) s += red[(w * 3 + j) * 256 + cc];
                TAB[TAB_MOD / 4 + (layer * 3 + j) * 6144 + cg * 256 + cc] = s; }
            __syncthreads();
        } else if (task == 48) {
            for (int k = tid; k < 1024; k += 512) { const float l0 = a.in[10][k], l1 = a.in[10][1024 + k]; TAB[TAB_LB / 4 + k] = 1.f / (1.f + expf(l1 - l0)); }
        } else if (task == 49) {
            if (wave == 0) { const float* lv = a.in[14]; const float sa = wave_sum(lv[lane] * lv[64 + lane]), sb = wave_sum(lv[128 + lane] * lv[192 + lane]);
                if (lane == 0) { TAB[TAB_LAM / 4] = expf(sa) - expf(sb) + LAM_INIT; TAB[TAB_LAM / 4 + 1] = 1.f - LAM_INIT; } }
        } else {
            for (int idx = tid; idx < 192 * 16; idx += 512) { const int pos = idx >> 4, i = idx & 15; const int p = pos < 128 ? pos : pos - 128;
                const float freq = powf(10000.f, -(float)i / 16.f), ang = (float)p * freq; TAB[TAB_ROPE / 4 + idx * 2] = cosf(ang); TAB[TAB_ROPE / 4 + idx * 2 + 1] = sinf(ang); }
        }
    }
    __syncthreads();
    LAS float* scr = (LAS float*)(lds + wave * 16384);
    const int ntask = G > 102 ? 51 : 0;
    if (vcu < ntask) return;
    const int gw = (vcu - ntask) * NWAVES + wave, NGW = (G - ntask) * NWAVES;
    constexpr int I_HIN = 16 * 160, I_HOUT = 16 * 32, I_DIN = 16 * 96, I_DOUT = 16 * 32, NITEMS = I_HIN + I_HOUT + I_DIN + I_DOUT;
    for (int it = gw; it < NITEMS; it += NGW) {
        int r = it;
        if (r < I_HIN) { tr_item<0>(a.in[9], 1024, 5120, (bf16*)(ws + WS_WHIN), 0, scr, r, lane); continue; } r -= I_HIN;
        if (r < I_HOUT) { tr_item<0>(a.in[12], 1024, 1024, (bf16*)(ws + WS_WHOUT), 0, scr, r, lane); continue; } r -= I_HOUT;
        if (r < I_DIN) { tr_item<2>(a.in[13], 1024, 3072, (bf16*)(ws + WS_WDIN), 0, scr, r, lane); continue; } r -= I_DIN;
        tr_item<0>(a.in[16], 1024, 1024, (bf16*)(ws + WS_WDOUT), 0, scr, r, lane);
    }
}
constexpr int BG_PER_MAT = 1408, BG_PER_LAYER = 48 * BG_PER_MAT, BG_WAVE = 33;
static_assert(BG_WAVE * 8 * 256 == BG_PER_LAYER, "static deal assumes 256 workgroups of 8 waves");
struct TrDesc { const float* W; bf16* WT; int K, N, row_off, mode, item; float scl; };
__device__ __forceinline__ TrDesc bg_desc(const Args& a, int r) {
    unsigned char* ws = a.ws; TrDesc d;
    const int mat = r / BG_PER_MAT, rr = r % BG_PER_MAT, layer = mat / 48, e = (mat % 48) / 3, which = mat % 3;
    d.item = rr; d.mode = which < 2 ? 1 : 0; d.scl = which == 0 ? 1.44269504f : (which == 1 ? 0.693147181f : 1.f);
    if (which < 2) { d.W = (which ? a.in[19] : a.in[18]) + (size_t)(layer * NE + e) * 1024 * FE; d.K = 1024; d.N = FE; d.WT = (bf16*)(ws + (layer ? WS_WGU1 : WS_WGU0)); d.row_off = e * 5632 + which * 128; }
    else { d.W = a.in[20] + (size_t)(layer * NE + e) * FE * 1024; d.K = FE; d.N = 1024; d.WT = (bf16*)(ws + (layer ? WS_WDN1 : WS_WDN0)); d.row_off = e * 1024; }
    return d;
}
__device__ __forceinline__ void tr_load(const TrDesc& d, f32x4 (&r)[8], int lane) {
    const int nblk = d.N / 32, kb = d.item / nblk, nb = d.item % nblk, k0 = 64 * kb, n0 = 32 * nb;
    const float* p = d.W + (size_t)(k0 + (lane >> 3)) * d.N + n0 + 4 * (lane & 7);
#pragma unroll
    for (int i = 0; i < 8; ++i) r[i] = *(const f32x4*)(p + (size_t)(8 * i) * d.N);
}
__device__ __forceinline__ void tr_finish(const TrDesc& d, const f32x4 (&r)[8], LAS float* scr, int lane) {
    const int nblk = d.N / 32, kb = d.item / nblk, nb = d.item % nblk, k0 = 64 * kb, n0 = 32 * nb;
#pragma unroll
    for (int i = 0; i < 8; ++i) { LAS float* w = scr + (8 * i + (lane >> 3)) * 33 + 4 * (lane & 7); w[0] = r[i][0]; w[1] = r[i][1]; w[2] = r[i][2]; w[3] = r[i][3]; }
    LDS_WAIT(); asm volatile("" ::: "memory");
    const int c = lane & 7;
#pragma unroll
    for (int j = 0; j < 4; ++j) { const int n = (lane >> 3) + 8 * j; const LAS float* s = scr + (8 * c) * 33 + n;
        const float sc_ = d.scl;
        u32x4 o; o.x = cvtpk(s[0 * 33] * sc_, s[1 * 33] * sc_); o.y = cvtpk(s[2 * 33] * sc_, s[3 * 33] * sc_); o.z = cvtpk(s[4 * 33] * sc_, s[5 * 33] * sc_); o.w = cvtpk(s[6 * 33] * sc_, s[7 * 33] * sc_);
        const int orow = d.mode ? tr_outrow<1>(d.row_off, n0 + n) : tr_outrow<0>(d.row_off, n0 + n);
        *(u32x4*)(d.WT + (size_t)orow * d.K + k0 + 8 * c) = o; }
    LDS_WAIT(); asm volatile("" ::: "memory");
}
__device__ __forceinline__ void bg_convert(const Args& a, LAS unsigned char* lds, int target, unsigned* donep, int G) {
    const int tid = threadIdx.x, lane = tid & 63, wave = __builtin_amdgcn_readfirstlane(tid >> 6);
    volatile LAS unsigned* curp = (volatile LAS unsigned*)(lds + MISC_OFF) + 24 + wave;
    LAS float* scr = (LAS float*)(lds + wave * 16384);
    volatile LAS unsigned* stopf = (volatile LAS unsigned*)(lds + MISC_OFF) + 20;
    if (tid == 0) *stopf = 0u;
    __syncthreads();
    if (donep && tid == 0) __hip_atomic_fetch_add(donep, 1u, __ATOMIC_RELAXED, __HIP_MEMORY_SCOPE_AGENT);
    if (G != 256) { if (!donep) {
            for (int l = 0; l < target / BG_WAVE; ++l) for (int it = (int)blockIdx.x * NWAVES + wave; it < BG_PER_LAYER; it += G * NWAVES) { f32x4 rr_[8]; const TrDesc dd = bg_desc(a, l * BG_PER_LAYER + it); tr_load(dd, rr_, lane); tr_finish(dd, rr_, scr, lane); } }
        return; }
    const int gw = (int)blockIdx.x * NWAVES + wave;
    unsigned cur = *curp;
    if ((int)cur < target) {
        f32x4 r0[8], r1[8], r2[8], r3[8];
#define BG_ITEM_OF(cc) (((cc) >= (unsigned)BG_WAVE ? BG_PER_LAYER : 0) + ((int)(cc) - ((cc) >= (unsigned)BG_WAVE ? BG_WAVE : 0)) * (256 * NWAVES) + gw)
#define BG_LD(k, rr) do { if ((k) < rem) { const TrDesc d_ = bg_desc(a, BG_ITEM_OF(cur + (k))); tr_load(d_, rr, lane); } } while (0)
#define BG_FN(k, rr) do { const TrDesc d_ = bg_desc(a, BG_ITEM_OF(cur + (k))); tr_finish(d_, rr, scr, lane); } while (0)
        const int rem = target - (int)cur;
        BG_LD(0, r0); BG_LD(1, r1); BG_LD(2, r2);
        for (int k = 0; k < rem; k += 4) {
            BG_LD(k + 3, r3); BG_FN(k, r0);
            if (k + 1 >= rem) break;
            BG_LD(k + 4, r0); BG_FN(k + 1, r1);
            if (k + 2 >= rem) break;
            BG_LD(k + 5, r1); BG_FN(k + 2, r2);
            if (k + 3 >= rem) break;
            BG_LD(k + 6, r2); BG_FN(k + 3, r3);
        }
        cur += (unsigned)rem;
#undef BG_ITEM_OF
#undef BG_LD
#undef BG_FN
    }
    *curp = cur;
}

template <bool ROUTER> __device__ __forceinline__ void norm_phase(const float* xlat, const float* xctx, int nrows, const float* gw_, const float* mod, int sh_idx, int sc_idx,
                                                                  bf16* H, const float* wrt, float* AFF, LAS unsigned char* lds, int vcu, int G) {
    const int tid = threadIdx.x, lane = tid & 63, wave = __builtin_amdgcn_readfirstlane(tid >> 6);
    LAS float* wl = (LAS float*)lds;
    if (ROUTER) { for (int idx = tid; idx < 16384; idx += 512) { const int c = idx >> 4, e = idx & 15; wl[e * 1024 + c] = wrt[idx]; } __syncthreads(); }
    const int gwv = vcu * NWAVES + wave, NGW = G * NWAVES;
    f32x4 vn[4];
    if (gwv < nrows) { const float* s0 = gwv < RL ? xlat + (size_t)gwv * 1024 : xctx + (size_t)(gwv - RL) * 1024;
#pragma unroll
        for (int j = 0; j < 4; ++j) vn[j] = *(const f32x4*)(s0 + 4 * lane + 256 * j); }
    for (int row = gwv; row < nrows; row += NGW) {
        const int rc = row < TL ? 0 : (row < RL ? 1 : 2);
        f32x4 v[4]; float ss = 0.f;
#pragma unroll
        for (int j = 0; j < 4; ++j) { v[j] = vn[j]; ss += (v[j][0] * v[j][0] + v[j][1] * v[j][1]) + (v[j][2] * v[j][2] + v[j][3] * v[j][3]); }
        { const int nr = row + NGW; if (nr < nrows) { const float* s1 = nr < RL ? xlat + (size_t)nr * 1024 : xctx + (size_t)(nr - RL) * 1024;
#pragma unroll
            for (int j = 0; j < 4; ++j) vn[j] = *(const f32x4*)(s1 + 4 * lane + 256 * j); } }
        const float rstd = rsqrtf(wave_sum(ss) * (1.f / 1024.f) + EPS);
        const float* scp = mod + rc * 6144 + sc_idx * 1024; const float* shp = mod + rc * 6144 + sh_idx * 1024;
        f32x4 hv[4];
#pragma unroll
        for (int j = 0; j < 4; ++j) { const int c = 4 * lane + 256 * j; const f32x4 g = *(const f32x4*)(gw_ + c), sc = *(const f32x4*)(scp + c), sh = *(const f32x4*)(shp + c);
            hv[j] = v[j] * rstd * g * (sc + 1.f) + sh;
            u32x2 w; w.x = cvtpk(hv[j][0], hv[j][1]); w.y = cvtpk(hv[j][2], hv[j][3]); *(u32x2*)(H + (size_t)row * 1024 + c) = w; }
        if (ROUTER) {
            float lg[16];
#pragma unroll
            for (int e = 0; e < 16; ++e) { float s = 0.f;
#pragma unroll
                for (int j = 0; j < 4; ++j) { const f32x4 w = *(const LAS f32x4*)(wl + e * 1024 + 4 * lane + 256 * j); s += (hv[j][0] * w[0] + hv[j][1] * w[1]) + (hv[j][2] * w[2] + hv[j][3] * w[3]); }
                lg[e] = wave_sum(s); }
            float mx = lg[0];
#pragma unroll
            for (int e = 1; e < 16; ++e) mx = fmaxf(mx, lg[e]);
            float den = 0.f;
#pragma unroll
            for (int e = 0; e < 16; ++e) { lg[e] = expf(lg[e] - mx); den += lg[e]; }
            float mine = 0.f;
#pragma unroll
            for (int e = 0; e < 16; ++e) mine = (lane == e) ? lg[e] : mine;
            if (lane < 16) AFF[(size_t)row * 16 + lane] = mine / den;
        }
    }
}
template <bool FINAL> __device__ __forceinline__ void combine_phase(const float* XA, int nrows, const int* SLOT, const float* AFF, const bf16* Y, const bf16* Y2, const float* mod_cur  ,
                                                                    float* XB, const float* gnext, const float* mod_next, bf16* H, float* out, int vcu, int G) {
    const int tid = threadIdx.x, lane = tid & 63, wave = __builtin_amdgcn_readfirstlane(tid >> 6);
    const int gwv = vcu * NWAVES + wave, NGW = G * NWAVES;
    int sl_n = 0; float af_n = 0.f; f32x4 xn[4];
    if (gwv < nrows) { sl_n = SLOT[(size_t)gwv * 16 + (lane & 15)]; af_n = AFF[(size_t)gwv * 16 + (lane & 15)];
#pragma unroll
        for (int j = 0; j < 4; ++j) xn[j] = *(const f32x4*)(XA + (size_t)gwv * 1024 + 4 * lane + 256 * j); }
    for (int row = gwv; row < nrows; row += NGW) {
        const int rc = row < TL ? 0 : (row < RL ? 1 : 2);
        const int ybase = row < RL ? (row >> 13) * CAPL : 2 * CAPL + ((row - RL) >> 8) * CAPC;
        const int sl = sl_n; const float af = af_n; f32x4 xc[4];
#pragma unroll
        for (int j = 0; j < 4; ++j) xc[j] = xn[j];
        { const int nr = row + NGW; if (nr < nrows) { sl_n = SLOT[(size_t)nr * 16 + (lane & 15)]; af_n = AFF[(size_t)nr * 16 + (lane & 15)];
#pragma unroll
            for (int j = 0; j < 4; ++j) xn[j] = *(const f32x4*)(XA + (size_t)nr * 1024 + 4 * lane + 256 * j); } }
        f32x4 acc[4];
#pragma unroll
        for (int j = 0; j < 4; ++j) acc[j] = (f32x4){0.f, 0.f, 0.f, 0.f};
        for (int e = 0; e < 16; ++e) { const int s = __shfl(sl, e); const float g = __shfl(af, e);
            if (s >= 0) { const bf16* yr = Y + ((size_t)e * MROWS + ybase + s) * 1024 + 4 * lane;
#pragma unroll
                for (int j = 0; j < 4; ++j) { const u32x2 w = *(const u32x2*)(yr + 256 * j);
                    acc[j][0] += g * __uint_as_float(w.x << 16); acc[j][1] += g * __uint_as_float(w.x & 0xffff0000u); acc[j][2] += g * __uint_as_float(w.y << 16); acc[j][3] += g * __uint_as_float(w.y & 0xffff0000u); }
                if (!FINAL && row >= RL) { const bf16* yr2 = Y2 + ((size_t)e * MROWS + ybase + s) * 1024 + 4 * lane;
#pragma unroll
                    for (int j = 0; j < 4; ++j) { const u32x2 w = *(const u32x2*)(yr2 + 256 * j);
                        acc[j][0] += g * __uint_as_float(w.x << 16); acc[j][1] += g * __uint_as_float(w.x & 0xffff0000u); acc[j][2] += g * __uint_as_float(w.y << 16); acc[j][3] += g * __uint_as_float(w.y & 0xffff0000u); } } } }
        const float* gt = mod_cur + rc * 6144 + 5 * 1024;
        f32x4 v[4]; float ss = 0.f;
#pragma unroll
        for (int j = 0; j < 4; ++j) { const int c = 4 * lane + 256 * j; v[j] = xc[j] + *(const f32x4*)(gt + c) * acc[j];
            ss += (v[j][0] * v[j][0] + v[j][1] * v[j][1]) + (v[j][2] * v[j][2] + v[j][3] * v[j][3]); }
        const float rstd = rsqrtf(wave_sum(ss) * (1.f / 1024.f) + EPS);
        if (FINAL) {
#pragma unroll
            for (int j = 0; j < 4; ++j) { const int c = 4 * lane + 256 * j; *(f32x4*)(out + (size_t)row * 1024 + c) = v[j] * rstd * *(const f32x4*)(gnext + c); }
        } else {
            const float* scp = mod_next + rc * 6144 + 1 * 1024; const float* shp = mod_next + rc * 6144 + 0 * 1024;
#pragma unroll
            for (int j = 0; j < 4; ++j) { const int c = 4 * lane + 256 * j; *(f32x4*)(XB + (size_t)row * 1024 + c) = v[j];
                const f32x4 h = v[j] * rstd * *(const f32x4*)(gnext + c) * (*(const f32x4*)(scp + c) + 1.f) + *(const f32x4*)(shp + c);
                u32x2 w; w.x = cvtpk(h[0], h[1]); w.y = cvtpk(h[2], h[3]); *(u32x2*)(H + (size_t)row * 1024 + c) = w; }
        }
    }
}
__device__ __forceinline__ void topk_item(int set, int b, int e, const float* AFF, int* ROWIDX, int* SLOT, unsigned char* lds) {
    const int tid = threadIdx.x, lane = tid & 63, wave = tid >> 6;
    const int n = set ? TCX : TL, cap = set ? CAPC : CAPL, row0 = set ? RL + b * TCX : b * TL;
    unsigned* keys = (unsigned*)lds;
    unsigned* hist = (unsigned*)(lds + 32768);
    unsigned* misc = (unsigned*)(lds + 32768 + 1024);
    for (int t = tid; t < n; t += 512) keys[t] = __float_as_uint(AFF[(size_t)(row0 + t) * 16 + e]);
    __syncthreads();
    unsigned prefix = 0u, mask = 0u; int remaining = cap;
    for (int pass = 0; pass < 4; ++pass) {
        const int shift = 24 - 8 * pass;
        if (tid < 256) hist[tid] = 0u;
        __syncthreads();
        if (pass == 0) {
            for (int t = tid; t < n; t += 512) { const unsigned bin = keys[t] >> 24; unsigned long long todo = __ballot(1);
                while (todo) { const int leader = __ffsll((long long)todo) - 1; const unsigned lb = (unsigned)__builtin_amdgcn_readlane((int)bin, leader);     const unsigned long long same = __ballot(bin == lb) & todo;
                    if (lane == leader) atomicAdd(&hist[lb], (unsigned)__popcll(same)); todo &= ~same; } }
        } else {
            for (int t = tid; t < n; t += 512) { const unsigned k = keys[t]; if ((k & mask) == prefix) atomicAdd(&hist[(k >> shift) & 255u], 1u); }
        }
        __syncthreads();
        if (wave == 0) {
            unsigned c[4]; unsigned s = 0u;
#pragma unroll
            for (int j = 0; j < 4; ++j) { c[j] = hist[255 - 4 * lane - j]; s += c[j]; }
            unsigned incl = s;
#pragma unroll
            for (int o = 1; o < 64; o <<= 1) { const unsigned v = __shfl_up(incl, o); if (lane >= o) incl += v; }
            const unsigned excl = incl - s;
            if (excl < (unsigned)remaining && (unsigned)remaining <= incl) { unsigned run = excl; int bin = 0; unsigned nr = 0u; bool found = false;
#pragma unroll
                for (int j = 0; j < 4; ++j) { if (!found) { if (run + c[j] >= (unsigned)remaining) { bin = 255 - 4 * lane - j; nr = (unsigned)remaining - run; found = true; } else run += c[j]; } }
                misc[0] = (unsigned)bin; misc[1] = nr; }
        }
        __syncthreads();
        prefix |= misc[0] << shift; mask |= 255u << shift; remaining = (int)misc[1];
        __syncthreads();
    }
    const unsigned T = prefix;
    const int per = n >= 512 ? n / 512 : 1, t0 = tid * per, cnt = (t0 < n) ? per : 0;
    unsigned cg = 0u, ce = 0u;
    for (int j = 0; j < cnt; ++j) { const unsigned k = keys[t0 + j]; cg += (k > T) ? 1u : 0u; ce += (k == T) ? 1u : 0u; }
    const unsigned pk = cg | (ce << 16);
    unsigned incl = pk;
#pragma unroll
    for (int o = 1; o < 64; o <<= 1) { const unsigned v = __shfl_up(incl, o); if (lane >= o) incl += v; }
    if (lane == 63) misc[8 + wave] = incl;
    __syncthreads();
    unsigned wbase = 0u;
    for (int w = 0; w < wave; ++w) wbase += misc[8 + w];
    unsigned run = wbase + incl - pk;
    unsigned g_before = run & 0xffffu, e_before = run >> 16;
    const int xs_base = set ? 2 * CAPL + b * CAPC : b * CAPL;
    int* idxp = ROWIDX + e * MROWS + xs_base;
    for (int j = 0; j < cnt; ++j) { const int t = t0 + j; const unsigned k = keys[t];
        const bool take = (k > T) || (k == T && e_before < (unsigned)remaining);
        const int slot = (int)(g_before + (e_before < (unsigned)remaining ? e_before : (unsigned)remaining));
        SLOT[(size_t)(row0 + t) * 16 + e] = take ? slot : -1;
        if (take) idxp[slot] = row0 + t;
        g_before += (k > T) ? 1u : 0u; e_before += (k == T) ? 1u : 0u; }
    __syncthreads();
}
__device__ __forceinline__ int chunk_row0(int b, int tc) { return tc < 4 ? RL + b * TCX + tc * 64 : b * TL + (tc - 4) * 64; }
__device__ __forceinline__ int chunk_seq(int dir, int tc) { return dir ? (tc < 4 ? 3 - tc : 135 - tc) : tc; }

struct Gla1In { f32x2 lf[8]; };
__device__ __forceinline__ void gla1_load(Gla1In& in, int b, int h, int tc, const bf16* LF) {
    const int tid = threadIdx.x, kp = tid & 63, seg = tid >> 6, row0 = chunk_row0(b, tc);
#pragma unroll
    for (int j = 0; j < 8; ++j) { const unsigned w = *(const unsigned*)(LF + (size_t)(row0 + 8 * seg + j) * 1024 + h * 128 + 2 * kp); in.lf[j] = (f32x2){__uint_as_float(w << 16), __uint_as_float(w & 0xffff0000u)}; }
}
__device__ __forceinline__ void gla1_loadv(bf16x8 (&v)[2], int b, int h, int tc, const bf16* V) {
    const int tid = threadIdx.x, sr = tid >> 4, sc = (tid & 15) * 8, row0 = chunk_row0(b, tc);
    v[0] = *(const bf16x8*)(V + (size_t)(row0 + sr) * 1024 + h * 128 + sc); v[1] = *(const bf16x8*)(V + (size_t)(row0 + 32 + sr) * 1024 + h * 128 + sc);
}
template <int DIR> __device__ __forceinline__ void gla1_dir(const Gla1In& in, int b, int h, int tc, bf16* P, float* DD, unsigned char* lds) {
    const int tid = threadIdx.x, lane = tid & 63, wave = tid >> 6, r32 = lane & 31, hi = lane >> 5, kp = tid & 63, seg = tid >> 6;
    unsigned char* KHT = lds; unsigned char* VT = lds + 16384; float* TOT = (float*)(lds + 32768);
    const int n = chunk_seq(DIR, tc), chain = DIR * 16 + b * 8 + h;
    f32x2 c[8]; f32x2 run = {0.f, 0.f};
#pragma unroll
    for (int j = 0; j < 8; ++j) { run += in.lf[j]; c[j] = run; }
    *(f32x2*)(TOT + seg * 128 + 2 * kp) = run;
    __syncthreads();
    f32x2 off = {0.f, 0.f}, tot = {0.f, 0.f};
#pragma unroll
    for (int s = 0; s < 8; ++s) { const f32x2 t = *(const f32x2*)(TOT + s * 128 + 2 * kp); if (s < seg) off += t; tot += t; }
    unsigned w0[4], w1[4];
#pragma unroll
    for (int j = 0; j < 8; j += 2) { float a[2], bb[2];
#pragma unroll
        for (int q = 0; q < 2; ++q) { const f32x2 cc = off + c[j + q]; const f32x2 l = in.lf[j + q];
            a[q] = (1.f - __builtin_amdgcn_exp2f(l[0])) * __builtin_amdgcn_exp2f(DIR ? (cc[0] - l[0]) : (tot[0] - cc[0])); bb[q] = (1.f - __builtin_amdgcn_exp2f(l[1])) * __builtin_amdgcn_exp2f(DIR ? (cc[1] - l[1]) : (tot[1] - cc[1])); }
        w0[j >> 1] = cvtpk(a[0], a[1]); w1[j >> 1] = cvtpk(bb[0], bb[1]); }
    *(u32x4*)(KHT + KSWZ64(2 * kp, seg * 16)) = (u32x4){w0[0], w0[1], w0[2], w0[3]};
    *(u32x4*)(KHT + KSWZ64(2 * kp + 1, seg * 16)) = (u32x4){w1[0], w1[1], w1[2], w1[3]};
    if (seg == 0) *(f32x2*)(DD + (size_t)(chain * NCH + n) * 128 + 2 * kp) = (f32x2){__builtin_amdgcn_exp2f(tot[0]), __builtin_amdgcn_exp2f(tot[1])};
    __syncthreads();
    const int kb = wave >> 1, vh = wave & 1, vb = (int)(uintptr_t)VT + v_rd_base(lane);
    bf16x8 pa[4];
#pragma unroll
    for (int s = 0; s < 4; ++s) pa[s] = *(const bf16x8*)(KHT + KSWZ64(32 * kb + r32, (16 * s + 8 * hi) * 2));
    bf16* Pn = P + (size_t)(chain * NCH + n) * 16384;
#pragma unroll
    for (int jj = 0; jj < 2; ++jj) { const int d0 = 2 * vh + jj; f32x16 od = {};
        pvb(od, vb + d0 * 512, pa[0], pa[1], pa[2], pa[3]);
#pragma unroll
        for (int r = 0; r < 16; ++r) Pn[(32 * kb + crow(r, hi)) * 128 + 32 * d0 + r32] = (bf16)cvtpk_mf(od[r], 0.f); }
    __syncthreads();
}
__device__ __forceinline__ void gla1_item(Gla1In& fw, bf16x8 (&vin)[2], int b, int h, int tc, bool has_next, int nb, int nh, int ntc, const bf16* LFF, const bf16* LFB, const bf16* V, bf16* P, float* DD, unsigned char* lds) {
    const int tid = threadIdx.x;
    unsigned char* VT = lds + 16384;
    Gla1In bw; gla1_load(bw, b, h, tc, LFB);
    { const int sr = tid >> 4, sc = (tid & 15) * 8;
      *(bf16x8*)(VT + v_st(sr, sc)) = vin[0]; *(bf16x8*)(VT + v_st(32 + sr, sc)) = vin[1]; }
    gla1_dir<0>(fw, b, h, tc, P, DD, lds);
    if (has_next) { gla1_load(fw, nb, nh, ntc, LFF); gla1_loadv(vin, nb, nh, ntc, V); }
    gla1_dir<1>(bw, b, h, tc, P, DD, lds);
}
__device__ __forceinline__ void gla2_phase(const bf16* P, const float* DD, bf16* SS, int vcu, int G) {
    for (int gid = vcu * 512 + (int)threadIdx.x; gid < 131072; gid += G * 512) {
        const int chain = gid >> 12, rem = gid & 4095, k = rem >> 5, v4 = rem & 31;
        const size_t base = (size_t)chain * NCH * 16384 + k * 128 + v4 * 4; const float* dp = DD + (size_t)chain * NCH * 128 + k;
        f32x4 S = {0.f, 0.f, 0.f, 0.f};
#pragma unroll 6
        for (int n = 0; n < NCH; ++n) { const u32x2 pw = *(const u32x2*)(P + base + (size_t)n * 16384); const float d = dp[n * 128];
            const f32x4 p = {__uint_as_float(pw.x << 16), __uint_as_float(pw.x & 0xffff0000u), __uint_as_float(pw.y << 16), __uint_as_float(pw.y & 0xffff0000u)};
            u32x2 w; w.x = cvtpk(S[0], S[1]); w.y = cvtpk(S[2], S[3]); *(u32x2*)(SS + base + (size_t)n * 16384) = w;
            S = S * d + p; }
    }
}
struct GlaIn { f32x2 lf[8]; unsigned q[8]; bf16x8 v[2]; bf16x8 s[4]; };
template <int DIR> __device__ __forceinline__ void gla3_load(GlaIn& in, int b, int h, int tc, const bf16* Q, const bf16* LF, const bf16* V, const bf16* SS) {
    const int tid = threadIdx.x, kp = tid & 63, seg = tid >> 6, row0 = chunk_row0(b, tc), n = chunk_seq(DIR, tc), chain = DIR * 16 + b * 8 + h;
#pragma unroll
    for (int j = 0; j < 8; ++j) { const int p = 8 * seg + j, t = DIR ? 63 - p : p; const size_t o = (size_t)(row0 + t) * 1024 + h * 128 + 2 * kp;
        { const unsigned w = *(const unsigned*)(LF + o); in.lf[j] = (f32x2){__uint_as_float(w << 16), __uint_as_float(w & 0xffff0000u)}; } in.q[j] = *(const unsigned*)(Q + o); }
    const int sr = tid >> 4, sc = (tid & 15) * 8;
#pragma unroll
    for (int q = 0; q < 2; ++q) { const int p = sr + 32 * q, t = DIR ? 63 - p : p; in.v[q] = *(const bf16x8*)(V + (size_t)(row0 + t) * 1024 + h * 128 + sc); }
    const bf16* Sg = SS + (size_t)(chain * NCH + n) * 16384;
#pragma unroll
    for (int q = 0; q < 4; ++q) in.s[q] = *(const bf16x8*)(Sg + (size_t)(sr + 32 * q) * 128 + sc);
}
__device__ __forceinline__ void gla3_scale(const GlaIn& in, unsigned char* lds) {
    const int tid = threadIdx.x;
    const int kp = tid & 63, seg = tid >> 6;
    unsigned char* QIN = lds; unsigned char* QD = lds + 16384; unsigned char* KD = lds + 32768; unsigned char* QO = lds + 49152; unsigned char* KO = lds + 57344;
    unsigned char* VT = lds + 65536; unsigned char* ST = lds + 81920; float* TOT = (float*)(lds + 114688);
    f32x2 c[8]; f32x2 run = {0.f, 0.f};
#pragma unroll
    for (int j = 0; j < 8; ++j) { run += in.lf[j]; c[j] = run; }
    *(f32x2*)(TOT + seg * 128 + 2 * kp) = run;
    { const int sr = tid >> 4, sc = (tid & 15) * 8;
#pragma unroll
      for (int q = 0; q < 2; ++q) *(bf16x8*)(VT + v_st(sr + 32 * q, sc)) = in.v[q];
#pragma unroll
      for (int q = 0; q < 4; ++q) { const int kr = sr + 32 * q; *(bf16x8*)(ST + (kr >> 6) * 16384 + v_st(kr & 63, sc)) = in.s[q]; } }
    __syncthreads();
    { f32x2 cum[8]; f32x2 acc = {0.f, 0.f};
#pragma unroll
      for (int s = 0; s < 8; ++s) { cum[s] = acc; acc += *(const f32x2*)(TOT + s * 128 + 2 * kp); }
      f32x2 off = cum[0];
#pragma unroll
      for (int s = 1; s < 8; ++s) off = (seg == s) ? cum[s] : off;
      const f32x2 e0 = cum[2], e1 = cum[4], e2 = cum[6];
      const f32x2 mref = seg < 4 ? e0 : e2, rref = e1;
      const float em[2] = {__builtin_amdgcn_exp2f(mref[0]), __builtin_amdgcn_exp2f(mref[1])};
      const float er[2] = {__builtin_amdgcn_exp2f(seg < 4 ? rref[0] - mref[0] : mref[0] - rref[0]), __builtin_amdgcn_exp2f(seg < 4 ? rref[1] - mref[1] : mref[1] - rref[1])};
#pragma unroll
      for (int j = 0; j < 8; ++j) { const int p = 8 * seg + j; const f32x2 cc = off + c[j];
          const float k0 = 1.f - __builtin_amdgcn_exp2f(in.lf[j][0]), k1 = 1.f - __builtin_amdgcn_exp2f(in.lf[j][1]);
          const float q0 = __uint_as_float(in.q[j] << 16), q1 = __uint_as_float(in.q[j] & 0xffff0000u);
          const int a = KSWZ(p, kp * 4);
          const float qd0 = q0 * __builtin_amdgcn_exp2f(cc[0] - mref[0]), qd1 = q1 * __builtin_amdgcn_exp2f(cc[1] - mref[1]);
          const float kd0 = k0 * __builtin_amdgcn_exp2f(mref[0] - cc[0]), kd1 = k1 * __builtin_amdgcn_exp2f(mref[1] - cc[1]);
          *(unsigned*)(QIN + a) = cvtpk(qd0 * em[0], qd1 * em[1]);
          *(unsigned*)(QD + a) = cvtpk(qd0, qd1);
          *(unsigned*)(KD + a) = cvtpk(kd0, kd1);
          if (seg < 4) *(unsigned*)(KO + a) = cvtpk(kd0 * er[0], kd1 * er[1]);
          else *(unsigned*)(QO + KSWZ(p - 32, kp * 4)) = cvtpk(qd0 * er[0], qd1 * er[1]); } }
    __syncthreads();
}
__device__ __forceinline__ f32x16 gla3_mma(unsigned char* lds) {
    const int tid = threadIdx.x, lane = tid & 63, wave = tid >> 6, r32 = lane & 31, hi = lane >> 5;
    unsigned char* QIN = lds; unsigned char* QD = lds + 16384; unsigned char* KD = lds + 32768; unsigned char* QO = lds + 49152; unsigned char* KO = lds + 57344;
    unsigned char* VT = lds + 65536; unsigned char* ST = lds + 81920;
    const int i = wave >> 2, d0 = wave & 3;
    const int vbV = (int)(uintptr_t)VT + v_rd_base(lane) + d0 * 512, vbS = (int)(uintptr_t)ST + v_rd_base(lane) + d0 * 512;
    f32x16 od = {};
    { bf16x8 qa[8];
#pragma unroll
      for (int s = 0; s < 8; ++s) qa[s] = *(const bf16x8*)(QIN + KSWZ(32 * i + r32, (16 * s + 8 * hi) * 2));
      pvb(od, vbS, qa[0], qa[1], qa[2], qa[3]); pvb(od, vbS + 16384, qa[4], qa[5], qa[6], qa[7]); }
    f32x16 pd = {};
#pragma unroll
    for (int s = 0; s < 8; ++s) { const int cb = (16 * s + 8 * hi) * 2;
        pd = __builtin_amdgcn_mfma_f32_32x32x16_bf16(*(const bf16x8*)(KD + KSWZ(32 * i + r32, cb)), *(const bf16x8*)(QD + KSWZ(32 * i + r32, cb)), pd, 0, 0, 0); }
#pragma unroll
    for (int r = 0; r < 16; ++r) pd[r] = (crow(r, hi) <= r32) ? pd[r] : 0.f;
    f32x16 p0, p1;
    if (i == 1) { f32x16 po = {};
#pragma unroll
        for (int s = 0; s < 8; ++s) { const int cb = (16 * s + 8 * hi) * 2;
            po = __builtin_amdgcn_mfma_f32_32x32x16_bf16(*(const bf16x8*)(KO + KSWZ(r32, cb)), *(const bf16x8*)(QO + KSWZ(r32, cb)), po, 0, 0, 0); }
        p0 = po; p1 = pd; }
    else { p0 = pd; p1 = (f32x16){}; }
    bf16x8 pa0, pa1, pa2, pa3;
    PK4(p0, 0, pa0); PK4(p0, 8, pa1); PK4(p1, 0, pa2); PK4(p1, 8, pa3);
    pvb(od, vbV, pa0, pa1, pa2, pa3);
    __syncthreads();
    return od;
}
__device__ __forceinline__ void gla3_item(GlaIn& cur, int b, int h, int tc, bool has_next, int nb, int nh, int ntc, const bf16* Q, const bf16* LFF, const bf16* LFB, const bf16* V, const bf16* SG, const bf16* SS, const float* gn, bf16* OM, unsigned char* lds) {
    const int tid = threadIdx.x, lane = tid & 63, wave = tid >> 6, r32 = lane & 31, hi = lane >> 5, row0 = chunk_row0(b, tc);
    GlaIn bw;
    gla3_scale(cur, lds); gla3_load<1>(bw, b, h, tc, Q, LFB, V, SS);
    const f32x16 of = gla3_mma(lds);
    gla3_scale(bw, lds); if (has_next) gla3_load<0>(cur, nb, nh, ntc, Q, LFF, V, SS);
    const f32x16 ob = gla3_mma(lds);
    float* OUT = (float*)lds;
    const int i = wave >> 2, d0 = wave & 3;
    unsigned sgw[8];
#pragma unroll
    for (int rr = 0; rr < 8; ++rr) sgw[rr] = *(const unsigned*)(SG + (size_t)(row0 + 8 * wave + rr) * 1024 + h * 128 + 2 * lane);
#pragma unroll
    for (int r = 0; r < 16; ++r) OUT[(32 * i + crow(r, hi)) * 132 + 32 * d0 + r32] = of[r];
    __syncthreads();
#pragma unroll
    for (int r = 0; r < 16; ++r) OUT[(63 - (32 * i + crow(r, hi))) * 132 + 32 * d0 + r32] += ob[r];
    __syncthreads();
    const f32x2 g = *(const f32x2*)(gn + 2 * lane);
#pragma unroll
    for (int rr = 0; rr < 8; ++rr) { const int t = 8 * wave + rr; const f32x2 o = *(const f32x2*)(OUT + t * 132 + 2 * lane);
        const float rstd = rsqrtf(wave_sum(o[0] * o[0] + o[1] * o[1]) * (1.f / 128.f) + EPS);
        const size_t off = (size_t)(row0 + t) * 1024 + h * 128 + 2 * lane;
        *(unsigned*)(OM + off) = cvtpk(o[0] * rstd * g[0] * __uint_as_float(sgw[rr] << 16), o[1] * rstd * g[1] * __uint_as_float(sgw[rr] & 0xffff0000u)); }
    __syncthreads();
}
constexpr int AT_STG = 32768, AT_KOFF = 16384, AT_Q = 65536, AT_LI = 131072, ATT_NT = 132;
__device__ __forceinline__ void att_exp16(f32x16& p, bool need, float sh) {
#pragma unroll
    for (int r = 0; r < 16; ++r) p[r] = __builtin_amdgcn_exp2f(p[r]);
}
__device__ __forceinline__ void att_soft(f32x16& p0, f32x16& p1, float& l_reg, bf16x8& pa0, bf16x8& pa1, bf16x8& pa2, bf16x8& pa3, bool need, float sh) {
    att_exp16(p0, need, sh); att_exp16(p1, need, sh);
    float s0 = 0.f, s1 = 0.f, s2 = 0.f, s3 = 0.f;
#pragma unroll
    for (int r = 0; r < 16; r += 4) { s0 += p0[r]; s1 += p0[r + 1]; s2 += p0[r + 2]; s3 += p0[r + 3]; }
#pragma unroll
    for (int r = 0; r < 16; r += 4) { s0 += p1[r]; s1 += p1[r + 1]; s2 += p1[r + 2]; s3 += p1[r + 3]; }
    l_reg += (s0 + s1) + (s2 + s3);
#define PK4N(P, BASE, OUT) do { u32x4 w_ = {cvtpk(P[BASE + 0], P[BASE + 1]), cvtpk(P[BASE + 2], P[BASE + 3]), cvtpk(P[BASE + 4], P[BASE + 5]), cvtpk(P[BASE + 6], P[BASE + 7])}; OUT = *reinterpret_cast<bf16x8*>(&w_); } while (0)
    PK4N(p0, 0, pa0); PK4N(p0, 8, pa1); PK4N(p1, 0, pa2); PK4N(p1, 8, pa3);
#undef PK4N
}
template <int COMP> __device__ __forceinline__ void att_qkt(f32x16& p0, f32x16& p1, const unsigned char* Ks, const unsigned char* ql, int koff0, const bf16x8* qreg, float ci) {
    f32x16 c0; for (int r = 0; r < 16; ++r) c0[r] = ci;
    const bf16x8* qr = (const bf16x8*)ql;
    p0 = __builtin_amdgcn_mfma_f32_32x32x16_bf16(*reinterpret_cast<const bf16x8*>(Ks + koff0 + (4 * COMP) * 2048), qreg[4 * COMP], c0, 0, 0, 0);
    p1 = __builtin_amdgcn_mfma_f32_32x32x16_bf16(*reinterpret_cast<const bf16x8*>(Ks + koff0 + 1024 + (4 * COMP) * 2048), qreg[4 * COMP], c0, 0, 0, 0);
#pragma unroll
    for (int d = 1; d < 4; ++d) { const int d0 = 4 * COMP + d;
        p0 = __builtin_amdgcn_mfma_f32_32x32x16_bf16(*reinterpret_cast<const bf16x8*>(Ks + koff0 + d0 * 2048), qreg[d0], p0, 0, 0, 0);
        p1 = __builtin_amdgcn_mfma_f32_32x32x16_bf16(*reinterpret_cast<const bf16x8*>(Ks + koff0 + 1024 + d0 * 2048), qreg[d0], p1, 0, 0, 0); }
}
template <int BO> __device__ __forceinline__ void pvb_t(f32x16& od, int vb, bf16x8 pa0, bf16x8 pa1, bf16x8 pa2, bf16x8 pa3) {
    const s16x4 l0 = tr_read<BO + v_rd_off(0, 0, 0)>(vb), h0 = tr_read<BO + v_rd_off(0, 0, 1)>(vb), l1 = tr_read<BO + v_rd_off(0, 1, 0)>(vb), h1 = tr_read<BO + v_rd_off(0, 1, 1)>(vb);
    const s16x4 l2 = tr_read<BO + v_rd_off(0, 2, 0)>(vb), h2 = tr_read<BO + v_rd_off(0, 2, 1)>(vb), l3 = tr_read<BO + v_rd_off(0, 3, 0)>(vb), h3 = tr_read<BO + v_rd_off(0, 3, 1)>(vb);
    asm volatile("s_waitcnt lgkmcnt(0)" ::: "memory"); SBAR();
#define PKV(L, H) (bf16x8){L[0], L[1], L[2], L[3], H[0], H[1], H[2], H[3]}
    od = __builtin_amdgcn_mfma_f32_32x32x16_bf16(pa0, PKV(l0, h0), od, 0, 0, 0);
    od = __builtin_amdgcn_mfma_f32_32x32x16_bf16(pa1, PKV(l1, h1), od, 0, 0, 0);
    od = __builtin_amdgcn_mfma_f32_32x32x16_bf16(pa2, PKV(l2, h2), od, 0, 0, 0);
    od = __builtin_amdgcn_mfma_f32_32x32x16_bf16(pa3, PKV(l3, h3), od, 0, 0, 0);
#undef PKV
}
#define TR8(BO, L0, H0, L1, H1, L2, H2, L3, H3) do { L0 = tr_read<BO + v_rd_off(0, 0, 0)>(vb); H0 = tr_read<BO + v_rd_off(0, 0, 1)>(vb); L1 = tr_read<BO + v_rd_off(0, 1, 0)>(vb); H1 = tr_read<BO + v_rd_off(0, 1, 1)>(vb); \
    L2 = tr_read<BO + v_rd_off(0, 2, 0)>(vb); H2 = tr_read<BO + v_rd_off(0, 2, 1)>(vb); L3 = tr_read<BO + v_rd_off(0, 3, 0)>(vb); H3 = tr_read<BO + v_rd_off(0, 3, 1)>(vb); } while (0)
#define PKV(L, H) (bf16x8){L[0], L[1], L[2], L[3], H[0], H[1], H[2], H[3]}
#define MM4(OD, L0, H0, L1, H1, L2, H2, L3, H3) do { OD = __builtin_amdgcn_mfma_f32_32x32x16_bf16(pa0, PKV(L0, H0), OD, 0, 0, 0); OD = __builtin_amdgcn_mfma_f32_32x32x16_bf16(pa1, PKV(L1, H1), OD, 0, 0, 0); \
    OD = __builtin_amdgcn_mfma_f32_32x32x16_bf16(pa2, PKV(L2, H2), OD, 0, 0, 0); OD = __builtin_amdgcn_mfma_f32_32x32x16_bf16(pa3, PKV(L3, H3), OD, 0, 0, 0); } while (0)
template <int VO> __device__ __forceinline__ void att_pv(f32x16* o, int vb, bf16x8 pa0, bf16x8 pa1, bf16x8 pa2, bf16x8 pa3) {
    s16x4 al0, ah0, al1, ah1, al2, ah2, al3, ah3, bl0, bh0, bl1, bh1, bl2, bh2, bl3, bh3;
    TR8(VO, al0, ah0, al1, ah1, al2, ah2, al3, ah3);
    TR8(VO + 512, bl0, bh0, bl1, bh1, bl2, bh2, bl3, bh3);
    asm volatile("s_waitcnt lgkmcnt(8)" ::: "memory"); SBAR(); MM4(o[0], al0, ah0, al1, ah1, al2, ah2, al3, ah3); SBAR();
    TR8(VO + 1024, al0, ah0, al1, ah1, al2, ah2, al3, ah3);
    asm volatile("s_waitcnt lgkmcnt(8)" ::: "memory"); SBAR(); MM4(o[1], bl0, bh0, bl1, bh1, bl2, bh2, bl3, bh3); SBAR();
    TR8(VO + 1536, bl0, bh0, bl1, bh1, bl2, bh2, bl3, bh3);
    asm volatile("s_waitcnt lgkmcnt(8)" ::: "memory"); SBAR(); MM4(o[2], al0, ah0, al1, ah1, al2, ah2, al3, ah3); SBAR();
    asm volatile("s_waitcnt lgkmcnt(0)" ::: "memory"); SBAR(); MM4(o[3], bl0, bh0, bl1, bh1, bl2, bh2, bl3, bh3);
}
#undef TR8
#undef PKV
#undef MM4
__device__ __forceinline__ void attn_item(const bf16* __restrict__ QA, const bf16* __restrict__ KA, const bf16* __restrict__ VA, bf16* __restrict__ OM, const unsigned* __restrict__ KMX,
                                          const float* __restrict__ lamp, const float* __restrict__ subln, int b, int h, int qb, unsigned char* lds) {
    const int tid = threadIdx.x, wid = tid >> 6, lane = tid & 63, r32 = lane & 31, hi = lane >> 5;
    float l0 = 0.f, l1 = 0.f; f32x16 o0[4] = {}, o1[4] = {};
    const int qrow0 = b * TL + qb * 256 + wid * 32;
    unsigned char* qlds = lds + AT_Q + wid * 8192 + lane * 16;
    float sh; bool need; bf16x8 qreg0[8];
    { const bf16* Qw = QA + (size_t)(qrow0 + r32) * 1024 + h * 128 + hi * 8; float q2a = 0.f, q2b = 0.f;
#pragma unroll
      for (int d0 = 0; d0 < 8; ++d0) { const bf16x8 qv = *reinterpret_cast<const bf16x8*>(Qw + d0 * 16); *(bf16x8*)(qlds + d0 * 1024) = qv; qreg0[d0] = qv; float s = 0.f;
#pragma unroll
          for (int j = 0; j < 8; ++j) { const float x = bf2f((unsigned short)qv[j]); s += x * x; }
          if (d0 < 4) q2a += s; else q2b += s; }
      q2a += __shfl_xor(q2a, 32); q2b += __shfl_xor(q2b, 32);
      const unsigned* km = KMX + b * 32 + h * 4;
      const float ma = sqrtf(q2a * (__uint_as_float(km[0]) + __uint_as_float(km[1]))), mb = sqrtf(q2b * (__uint_as_float(km[2]) + __uint_as_float(km[3])));
      const float mrow = fmaxf(ma, mb) * 1.01f + 0.01f;
      sh = mrow > 60.f ? mrow - 60.f : 0.f; need = __any(sh > 0.f); }
    const float cinit = -sh;
    const int koff0 = AT_KOFF + r32 * 32 + ((hi ^ ((r32 >> 3) & 1)) << 4);
    const int vb0 = (int)(uintptr_t)lds + v_rd_base(lane);
    const int wu = __builtin_amdgcn_readfirstlane(wid);
    unsigned goff0;
    { const int pc = wu * 4; int key, col;
      if (pc < 16) { const int sub = 2 * pc + (lane >> 5), kk = (sub >> 2) * 8 + ((lane & 31) >> 2); key = kk; col = (sub & 3) * 32 + (lane & 3) * 8; }
      else { const int q = pc - 16; key = (q & 1) * 32 + (lane >> 1); col = (q >> 1) * 16 + (((lane & 1) ^ ((key >> 3) & 1)) << 3); }
      goff0 = (unsigned)(key * 1024 + h * 128 + col) * 2u; }
    const int gd1 = (wu < 4) ? 64 : 32 * 1024, gd2 = (wu < 4) ? 8 * 1024 : 16;
    const bf16* srcb = (wu < 4) ? VA : KA;
    const int ldst = (wu < 4 ? 0 : AT_KOFF - 16384) + wu * 4096;
#define TROW(j) ((j) < 4 ? (RL + b * TCX + (j) * 64) : (b * TL + ((j) - 4) * 64))
#define SDMA(st, j) do { const bf16* tb_ = srcb + (size_t)TROW(j) * 1024; unsigned g_ = goff0; asm volatile("" : "+v"(g_));   \
        _Pragma("unroll") for (int i_ = 0; i_ < 4; ++i_) \
        __builtin_amdgcn_global_load_lds((const unsigned*)((const char*)(tb_ + (i_ & 1) * gd1 + (i_ >> 1) * gd2) + g_), (LAS unsigned*)(lds + (st) * AT_STG + ldst + i_ * 1024), 16, 0, 0); } while (0)
    f32x16 pA0, pA1; bf16x8 pa0, pa1, pa2, pa3; constexpr int NT = ATT_NT;
#define STEP(ST, jj) do { __syncthreads(); \
        SDMA(1 - (ST), ((jj) + 1 < NT) ? (jj) + 1 : NT - 1); \
        SBAR(); att_qkt<0>(pA0, pA1, lds + (ST) * AT_STG, qlds, koff0, qreg0, cinit); \
        att_soft(pA0, pA1, l0, pa0, pa1, pa2, pa3, need, sh); \
        att_pv<(ST) * AT_STG>(o0, vb0, pa0, pa1, pa2, pa3); \
        att_qkt<1>(pA0, pA1, lds + (ST) * AT_STG, qlds, koff0, qreg0, cinit); \
        att_soft(pA0, pA1, l1, pa0, pa1, pa2, pa3, need, sh); \
        att_pv<(ST) * AT_STG>(o1, vb0, pa0, pa1, pa2, pa3); } while (0)
    SDMA(0, 0);
    for (int j = 0; j < NT; j += 2) {
        STEP(0, j);
        STEP(1, j + 1);
    }
    asm volatile("s_waitcnt vmcnt(0)" ::: "memory");
#undef STEP
#undef TROW
#undef SDMA
    l0 += __shfl_xor(l0, 32); l1 += __shfl_xor(l1, 32);
    int t2_ = tid; asm volatile("" : "+v"(t2_));
    const int r32e = t2_ & 31, hie = (t2_ >> 5) & 1; float* li_e = (float*)(lds + AT_LI) + (t2_ >> 6) * 64;
    if (hie == 0) { li_e[r32e] = l0; li_e[32 + r32e] = l1; } asm volatile("s_waitcnt lgkmcnt(0)" ::: "memory");
    const float lam = lamp[0], oml = lamp[1];
    float gsub[4];
#pragma unroll
    for (int d0 = 0; d0 < 4; ++d0) gsub[d0] = subln[d0 * 32 + r32e] * oml;
    bf16* Ow = OM + (size_t)(b * TL + qb * 256 + (t2_ >> 6) * 32) * 1024 + h * 128 + r32e;
#pragma unroll
    for (int r = 0; r < 16; ++r) { const int orow = crow(r, hie); const float ra = __builtin_amdgcn_rcpf(li_e[orow]), rb = lam * __builtin_amdgcn_rcpf(li_e[32 + orow]);
        float v[4]; float ss = 0.f;
#pragma unroll
        for (int d0 = 0; d0 < 4; ++d0) { v[d0] = o0[d0][r] * ra - o1[d0][r] * rb; ss += v[d0] * v[d0]; }
        ss += __shfl_xor(ss, 1); ss += __shfl_xor(ss, 2); ss += __shfl_xor(ss, 4); ss += __shfl_xor(ss, 8); ss += __shfl_xor(ss, 16);
        const float rstd = rsqrtf(ss * (1.f / 128.f) + EPS);
#pragma unroll
        for (int d0 = 0; d0 < 4; ++d0) Ow[(size_t)orow * 1024 + d0 * 32] = (bf16)cvtpk(v[d0] * rstd * gsub[d0], 0.f); }
    __syncthreads();
}
#ifndef MK_MULTI
#define MK_MULTI 0
#endif
constexpr int NPHASES = 20;
__global__ void __launch_bounds__(NWAVES * 64, 2) __attribute__((target("no-packed-fp32-ops"))) mk_fwd(Args args) {
    extern __shared__ __attribute__((aligned(16))) unsigned char lds[];
    LAS unsigned char* ldsL = (LAS unsigned char*)lds;
    const int tid = threadIdx.x, G = gridDim.x, bx = blockIdx.x;
    const int vcu = (G % 8 == 0) ? (bx % 8) * (G / 8) + bx / 8 : bx;
    unsigned char* ws = args.ws;
    for (int u = tid; u < (LDS_BYTES - 131072) / 4; u += NWAVES * 64) ((LAS unsigned*)(ldsL + 131072))[u] = 0u;
    __syncthreads();
    const int lo = args.ph_lo, hi = args.ph_hi;
    XcdBarrier bar; bar.bar = (unsigned*)(ws + WS_CTL) + CW_BAR; bar.x = 0; bar.st = (volatile LAS unsigned*)(ldsL + MISC_OFF) + 8;
    if (hi - lo > 1) bar = xcd_barrier_post((unsigned*)(ws + WS_CTL) + CW_BAR, (volatile LAS unsigned*)(ldsL + MISC_OFF) + 8);
#define IN(k) (lo <= (k) && (k) < hi)
#define SEAM(k) do { if (IN(k) && IN((k) + 1)) xcd_barrier(bar); } while (0)
    float* TAB = (float*)(ws + WS_TAB); float* MOD0 = TAB + TAB_MOD / 4; float* MOD1 = MOD0 + 3 * 6144;
    const float* LB = TAB + TAB_LB / 4; const float* LAM = TAB + TAB_LAM / 4; const float* ROPE = TAB + TAB_ROPE / 4;
    bf16* H = (bf16*)(ws + WS_H); bf16* OM = (bf16*)(ws + WS_OMIX); float* XA = (float*)(ws + WS_XA); float* XB = (float*)(ws + WS_XB);
    float* AFF = (float*)(ws + WS_AFF); int* SLOT = (int*)(ws + WS_SLOT); int* ROWIDX = (int*)(ws + WS_IDX);
    bf16* XS = (bf16*)(ws + WS_XS); bf16* ACT = (bf16*)(ws + WS_ACT); bf16* Y = (bf16*)(ws + WS_Y); bf16* Y2 = (bf16*)(ws + WS_Y2);
    unsigned* KMX = (unsigned*)(ws + WS_CTL) + CW_KMX;
    (void)LAM; (void)ROPE; (void)LB; (void)XB; (void)ROWIDX; (void)XS;

    if (IN(0)) { p0_prologue(args, ldsL, vcu, G); }
    SEAM(0);
    if (IN(1)) { norm_phase<false>(args.in[0], args.in[2], RT, args.in[6], MOD0, 0, 1, H, nullptr, nullptr, ldsL, vcu, G); }
    SEAM(1);
    if (IN(2)) { pg8::Gemm g{H, (const bf16*)(ws + WS_WHIN), RT, 5120, 1024, nullptr}; pg8::TailOrder S; S.init(64, 20, G, bx, 64, 0, 2, 20);
        pg8::EpiHin E{(bf16*)(ws + WS_Q), (bf16*)(ws + WS_LFF), (bf16*)(ws + WS_LFB), (bf16*)(ws + WS_V), (bf16*)(ws + WS_SG), LB};
        pg8::gemm_phase<pg8::EpiHin, pg8::TailOrder, true, true>(ldsL, g, S, E); }
    SEAM(2);
    if (IN(3)) { { Gla1In gin; bf16x8 vin[2] = {}; int it = vcu; if (it < NB * NH * NCH) { gla1_load(gin, (it / NCH) >> 3, (it / NCH) & 7, it % NCH, (const bf16*)(ws + WS_LFF)); gla1_loadv(vin, (it / NCH) >> 3, (it / NCH) & 7, it % NCH, (const bf16*)(ws + WS_V)); }
          for (; it < NB * NH * NCH; it += G) { const int tc = it % NCH, bh = it / NCH, nit = it + G; const bool hn = nit < NB * NH * NCH; const int nbh = hn ? nit / NCH : bh, ntc = hn ? nit % NCH : tc;
            gla1_item(gin, vin, bh >> 3, bh & 7, tc, hn, nbh >> 3, nbh & 7, ntc, (const bf16*)(ws + WS_LFF), (const bf16*)(ws + WS_LFB), (const bf16*)(ws + WS_V), (bf16*)(ws + WS_P), (float*)(ws + WS_DD), lds); } } }
    SEAM(3);
    if (IN(4)) { gla2_phase((const bf16*)(ws + WS_P), (const float*)(ws + WS_DD), (bf16*)(ws + WS_SS), vcu, G); }
    SEAM(4);
    if (IN(5)) { { GlaIn gin; int it = vcu; if (it < NB * NH * NCH) gla3_load<0>(gin, (it / NCH) >> 3, (it / NCH) & 7, it % NCH, (const bf16*)(ws + WS_Q), (const bf16*)(ws + WS_LFF), (const bf16*)(ws + WS_V), (const bf16*)(ws + WS_SS));
          for (; it < NB * NH * NCH; it += G) { const int tc = it % NCH, bh = it / NCH, nit = it + G; const bool hn = nit < NB * NH * NCH; const int nbh = hn ? nit / NCH : bh, ntc = hn ? nit % NCH : tc;
            gla3_item(gin, bh >> 3, bh & 7, tc, hn, nbh >> 3, nbh & 7, ntc, (const bf16*)(ws + WS_Q), (const bf16*)(ws + WS_LFF), (const bf16*)(ws + WS_LFB), (const bf16*)(ws + WS_V), (const bf16*)(ws + WS_SG),
                      (const bf16*)(ws + WS_SS), args.in[11], OM, lds); } } }
    SEAM(5);
    if (IN(6)) { pg8::Gemm g{OM, (const bf16*)(ws + WS_WHOUT), RT, 1024, 1024, nullptr}; pg8::TailOrder S; S.init(64, 4, G, bx, 64, 0, 2, 4);
        pg8::EpiResid E{args.in[0], args.in[2], MOD0 + 2 * 1024, XA};
        pg8::gemm_phase<pg8::EpiResid, pg8::TailOrder, true, true>(ldsL, g, S, E); }
    SEAM(6);
    if (IN(7)) { norm_phase<true>(XA, XA + (size_t)RL * 1024, RT, args.in[7], MOD0, 3, 4, H, args.in[17], AFF, ldsL, vcu, G); }
    SEAM(7);
    if (IN(8)) { for (int it = vcu; it < 64; it += G) topk_item(it >> 5, (it & 31) >> 4, it & 15, AFF, ROWIDX, SLOT, lds); bg_convert(args, ldsL, BG_WAVE, nullptr, G); }
    SEAM(8);
    if (IN(9)) { pg8::Gemm g{H, (const bf16*)(ws + WS_WGU0), NE * MROWS, NE * 5632, 1024, ROWIDX}; pg8::GroupedOrder S; S.init(22, G, bx, true, 1, 16);
        pg8::EpiMoe1 E{ACT}; pg8::gemm_phase<pg8::EpiMoe1, pg8::GroupedOrder, true, true, true>(ldsL, g, S, E); }
    SEAM(9);
    if (IN(10)) { pg8::Gemm g{ACT, (const bf16*)(ws + WS_WDN0), NE * MROWS, NE * 1024, FE, nullptr}; pg8::GroupedOrder S; S.init(4, G, bx, true, 2, 44);
        pg8::EpiMoe2 E{Y, Y2}; pg8::gemm_phase<pg8::EpiMoe2, pg8::GroupedOrder, true, true>(ldsL, g, S, E); }
    SEAM(10);
    if (IN(11)) { combine_phase<false>(XA, RT, SLOT, AFF, Y, Y2, MOD0, XB, args.in[6] + 1024, MOD1, H, nullptr, vcu, G); }
    SEAM(11);
    if (IN(12)) { pg8::Gemm g{H, (const bf16*)(ws + WS_WDIN), RT, 3072, 1024, nullptr}; pg8::TailOrder S; S.init(64, 12, G, bx, 64, 4, 2, 8);
        pg8::EpiDin E{(bf16*)(ws + WS_QA), (bf16*)(ws + WS_KA), (bf16*)(ws + WS_VA), ROPE, KMX};
        pg8::gemm_phase<pg8::EpiDin, pg8::TailOrder, true, true>(ldsL, g, S, E); }
    SEAM(12);
    if (IN(13)) {
        const int cslot = (int)(bx % 3);
        for (int i = 0;; ++i) { const int L = i * G + bx;
            if (i == cslot) { bg_convert(args, ldsL, 2 * BG_WAVE, nullptr, G); __syncthreads(); }
            if (L >= 512) break;
            int qb, grp; if (G == 256) { qb = bx >> 3; grp = i * 8 + (bx & 7); } else { qb = L & 31; grp = L >> 5; }
            attn_item((const bf16*)(ws + WS_QA), (const bf16*)(ws + WS_KA), (const bf16*)(ws + WS_VA), OM, KMX, LAM, args.in[15], grp >> 3, grp & 7, qb, lds); } }
    SEAM(13);
    if (IN(14)) { pg8::Gemm g{OM, (const bf16*)(ws + WS_WDOUT), RL, 1024, 1024, nullptr}; pg8::StaticOrder S; S.init(RL, 1024, G, bx);
        pg8::EpiResid E{XB, XB + (size_t)RL * 1024, MOD1 + 2 * 1024, XA};
        pg8::gemm_phase<pg8::EpiResid, pg8::StaticOrder, true, true>(ldsL, g, S, E); }
    SEAM(14);
    if (IN(15)) { norm_phase<true>(XA, XA + (size_t)RL * 1024, RL, args.in[7] + 1024, MOD1, 3, 4, H, args.in[17] + 16384, AFF, ldsL, vcu, G); }
    SEAM(15);
    if (IN(16)) { for (int it = vcu; it < 32; it += G) topk_item(0, it >> 4, it & 15, AFF, ROWIDX, SLOT, lds); bg_convert(args, ldsL, 2 * BG_WAVE, nullptr, G); }
    SEAM(16);
    if (IN(17)) { pg8::Gemm g{H, (const bf16*)(ws + WS_WGU1), NE * MROWS, NE * 5632, 1024, ROWIDX}; pg8::GroupedOrder S; S.init(22, G, bx, false, 1, 16);
        pg8::EpiMoe1 E{ACT}; pg8::gemm_phase<pg8::EpiMoe1, pg8::GroupedOrder, true, true, true>(ldsL, g, S, E); }
    SEAM(17);
    if (IN(18)) { pg8::Gemm g{ACT, (const bf16*)(ws + WS_WDN1), NE * MROWS, NE * 1024, FE, nullptr}; pg8::GroupedOrder S; S.init(4, G, bx, false, 1, 44);
        pg8::EpiMoe2 E{Y, Y2}; pg8::gemm_phase<pg8::EpiMoe2, pg8::GroupedOrder, true, true>(ldsL, g, S, E); }
    SEAM(18);
    if (IN(19)) { combine_phase<true>(XA, RL, SLOT, AFF, Y, Y2, MOD1, nullptr, args.in[8], nullptr, nullptr, args.out, vcu, G); }
#undef IN
#undef SEAM
}
extern "C" void kernel_launch(void* const* d_in, const int* in_sizes, int n_in, void* d_out, int out_size, void* d_ws, size_t ws_size, hipStream_t stream) {
    static int grid = 0;
    if (grid == 0) {
        if (n_in != 21 || out_size != RL * DM || ws_size < WS_END) { fprintf(stderr, "kernel_launch: unexpected shapes: n_in %d out %d ws %zu (need %zu)\n", n_in, out_size, ws_size, (size_t)WS_END); grid = -1; return; }
        int dev = 0, cus = 0;
        if (hipGetDevice(&dev) != hipSuccess || hipDeviceGetAttribute(&cus, hipDeviceAttributeMultiprocessorCount, dev) != hipSuccess) { grid = -1; return; }
        if (hipFuncSetAttribute((const void*)mk_fwd, hipFuncAttributeMaxDynamicSharedMemorySize, LDS_BYTES) != hipSuccess) { fprintf(stderr, "kernel_launch: hipFuncSetAttribute failed\n"); grid = -1; return; }
        int per_cu = 0;
        if (hipOccupancyMaxActiveBlocksPerMultiprocessor(&per_cu, (const void*)mk_fwd, NWAVES * 64, LDS_BYTES) != hipSuccess || per_cu < 1) fprintf(stderr, "kernel_launch: occupancy query says %d\n", per_cu);
        (void)hipGetLastError();
        grid = cus;
    }
    if (grid < 0) return;
    (void)hipMemsetAsync((char*)d_ws + WS_CTL, 0, CTL_ZERO_BYTES, stream);
    Args a{};
    for (int i = 0; i < 21; ++i) a.in[i] = (const float*)d_in[i];
    a.out = (float*)d_out; a.ws = (unsigned char*)d_ws;
#if MK_MULTI
    for (int ph = 0; ph < NPHASES; ++ph) { a.ph_lo = ph; a.ph_hi = ph + 1; hipLaunchKernelGGL(mk_fwd, dim3(grid), dim3(NWAVES * 64), LDS_BYTES, stream, a); }
#else
    a.ph_lo = 0; a.ph_hi = NPHASES; hipLaunchKernelGGL(mk_fwd, dim3(grid), dim3(NWAVES * 64), LDS_BYTES, stream, a);
#endif
    const hipError_t le = hipPeekAtLastError();
    if (le != hipSuccess) fprintf(stderr, "kernel_launch: launch failed: %s\n", hipGetErrorName(le));
}
```

```cpp
#include <hip/hip_runtime.h>
#include <cstdio>
#include <cstdint>
namespace pg8 {
#define PG8_LAS __attribute__((address_space(3)))
typedef unsigned short bf16_t;
typedef short bf16x8 __attribute__((ext_vector_type(8)));
typedef float f32x4 __attribute__((ext_vector_type(4)));
typedef unsigned u32x4 __attribute__((ext_vector_type(4)));
constexpr int BM = 256, BK = 64, HALF = 128, HTB = HALF * BK * 2  , STAGE_BYTES = 8 * HTB, NXCD = 8, WGM = 8;

__host__ __device__ __forceinline__ int lds_byte(int r, int c) { const int st = (r >> 4) * 2 + (c >> 5), rr = r & 15, cc = c & 31, ob = rr * 64 + cc * 2; return st * 1024 + (ob ^ (((ob >> 9) & 1) << 5)); }
__host__ __device__ __forceinline__ void stage_rc(int b, int& R, int& C) { const int st = b / 1024, sb = b % 1024, swz = sb ^ (((sb >> 9) & 1) << 5); R = (st >> 1) * 16 + swz / 64; C = (st & 1) * 32 + (swz % 64) / 2; }
__host__ __device__ __forceinline__ int perm32(int rho) { const int n = rho >> 4, i = rho & 15; return 8 * (i >> 2) + 4 * n + (i & 3); }

struct Unit { int pm, pn, nt, kofs, flags; };
struct Gemm { const bf16_t* A; const bf16_t* Bt; int M, N, K; const int* rowidx; };

struct StaticOrder {
    int nM, nN, nwg, G, c;
    __host__ __device__ __forceinline__ void init(int M, int N, int G_, int c_) { nM = M / BM; nN = N / BM; nwg = nM * nN; G = G_; c = c_; }
    __host__ __device__ __forceinline__ bool next(int i, Unit& u) const {
        const long L = (long)i * G + c; if (L >= nwg) return false;
        int wgid = (int)L; { const int q = nwg / NXCD, r = nwg % NXCD, xcd = wgid % NXCD, off = wgid / NXCD; wgid = (xcd < r ? xcd * (q + 1) : r * (q + 1) + (xcd - r) * q) + off; }
        const int nig = WGM * nN, gid = wgid / nig, fm = gid * WGM, gsz = (nM - fm) < WGM ? (nM - fm) : WGM;
        u.pm = fm + ((wgid % nig) % gsz); u.pn = (wgid % nig) / gsz; return true;
    }
    __device__ __forceinline__ void a_ready(const Unit&) const {}
    __device__ __forceinline__ void done(const Unit&) const {}
};

typedef float f32x2c_t __attribute__((ext_vector_type(2))); typedef __bf16 bf16x2c_t __attribute__((ext_vector_type(2)));
__device__ __forceinline__ unsigned cvt_pk_bf16(float lo, float hi) { const f32x2c_t v = {lo, hi}; const bf16x2c_t c = __builtin_convertvector(v, bf16x2c_t); return __builtin_bit_cast(unsigned, c); }
typedef float f32x2 __attribute__((ext_vector_type(2)));
template <class Epi, class Sched, bool ALIGN_EPI = false, bool SP2 = false, bool GATHER = false>
__device__ __forceinline__ void gemm_phase(PG8_LAS unsigned char* lds, const Gemm g, const Sched& S, const Epi& E) {
    const int tid = threadIdx.x, wid = __builtin_amdgcn_readfirstlane(tid >> 6), lane = tid & 63, wr = wid >> 2, wc = wid & 3, fr = lane & 15, fq = lane >> 4;
    const int K = g.K; int nt = K / BK;
    unsigned voffA[2], voffB[2];
#pragma unroll
    for (int i = 0; i < 2; ++i) { int R, C; stage_rc(tid * 16 + i * 8192, R, C); const int Rb = Epi::PERM ? ((R & ~31) + perm32(R & 31)) : R;
        voffA[i] = (unsigned)(R * K + C) * 2u; voffB[i] = (unsigned)(Rb * K + C) * 2u; }
    int gR[2], gC[2];
#pragma unroll
    for (int i = 0; i < 2; ++i) stage_rc(tid * 16 + i * 8192, gR[i], gC[i]);
    unsigned oc0[2] = {0u, 0u}, oc1[2] = {0u, 0u}, on0[2] = {0u, 0u}, on1[2] = {0u, 0u};
    PG8_LAS unsigned short* ridx = (PG8_LAS unsigned short*)(lds + STAGE_BYTES);
#define PG8_GOFF(o0, o1, uu, ord) do { _Pragma("unroll") for (int _i = 0; _i < 2; ++_i) { const int _lim = ((uu).flags & 1) ? 64 : 256; \
        const int _r0 = gR[_i], _r1 = HALF + gR[_i]; const int _i0 = _r0 < _lim ? (int)ridx[(ord) * 256 + _r0] : 0, _i1 = _r1 < _lim ? (int)ridx[(ord) * 256 + _r1] : 0; \
        o0[_i] = (unsigned)(_i0 * K + gC[_i]) * 2u; o1[_i] = (unsigned)(_i1 * K + gC[_i]) * 2u; } } while (0)
    const size_t kstep = (size_t)(BK * 2);
    const size_t hstep = (size_t)HALF * K * 2;
    const size_t hA = GATHER ? 0 : hstep;
    const size_t tstep = 2 * hstep;
    const unsigned ldsw = (unsigned)wid * 1024u;
    const int aoff = lds_byte(wr * 64 + fr, fq * 8), boff = lds_byte(wc * 32 + fr, fq * 8);
#define PG8_SA(b, h) (((b) * 2 + (h)) * HTB)
#define PG8_SB(b, h) ((4 + (b) * 2 + (h)) * HTB)
    const __amdgpu_buffer_rsrc_t rsA = __builtin_amdgcn_make_buffer_rsrc((void*)g.A, 0, 0x7FFFFFFF, 0x00027000), rsB = __builtin_amdgcn_make_buffer_rsrc((void*)g.Bt, 0, 0x7FFFFFFF, 0x00027000);
#define PG8_STAGE(bufoff, gbase, voff) do { const bool isb_ = (bufoff) >= 4 * HTB; const unsigned so_ = (unsigned)((const char*)(gbase) - (isb_ ? (const char*)g.Bt : (const char*)g.A)); \
        _Pragma("unroll") for (int _i = 0; _i < 2; ++_i) \
        __builtin_amdgcn_raw_ptr_buffer_load_lds(isb_ ? rsB : rsA, (PG8_LAS void*)(lds + (bufoff) + ldsw + _i * 8192), 16, (int)(voff)[_i], (int)so_, 0, 0); } while (0)
#define PG8_LDA(dst, b, h) do { _Pragma("unroll") for (int m = 0; m < 4; ++m) _Pragma("unroll") for (int k = 0; k < 2; ++k) dst[m][k] = *(const PG8_LAS bf16x8*)(lds + PG8_SA(b, h) + aoff + m * 2048 + k * 1024); } while (0)
#define PG8_LDB(dst, b, h) do { _Pragma("unroll") for (int n = 0; n < 2; ++n) _Pragma("unroll") for (int k = 0; k < 2; ++k) dst[n][k] = *(const PG8_LAS bf16x8*)(lds + PG8_SB(b, h) + boff + n * 2048 + k * 1024); } while (0)
#define PG8_MMA_(ai, bj, At, Bt, FZ) do { __builtin_amdgcn_s_setprio(1); _Pragma("unroll") for (int m = 0; m < 4; ++m) _Pragma("unroll") for (int n = 0; n < 2; ++n) _Pragma("unroll") for (int k = 0; k < 2; ++k) \
        acc[ai][bj][m][n] = __builtin_amdgcn_mfma_f32_16x16x32_bf16(Bt[n][k], At[m][k], ((FZ) && k == 0) ? (f32x4){0.f, 0.f, 0.f, 0.f} : acc[ai][bj][m][n], 0, 0, 0); __builtin_amdgcn_s_setprio(0); } while (0)
#define PG8_MMA(ai, bj, At, Bt) PG8_MMA_(ai, bj, At, Bt, false)
#define PG8_MMA0(ai, bj, At, Bt) do { if (SP2 && t == 0) PG8_MMA_(ai, bj, At, Bt, true); else PG8_MMA_(ai, bj, At, Bt, false); } while (0)
#define PG8_WAIT_V(n) asm volatile("s_waitcnt vmcnt(" #n ")" ::: "memory")
#define PG8_WAIT_L(n) asm volatile("s_waitcnt lgkmcnt(" #n ")" ::: "memory")
#define PG8_BAR __builtin_amdgcn_s_barrier()
#define PG8_SCHED __builtin_amdgcn_sched_barrier(0)
    Unit cur = {0, 0, 0, 0, 0}, nxt = {0, 0, 0, 0, 0}; int ui = 0;
    if (!S.next(0, cur)) return;
    if (cur.nt) nt = cur.nt;
    if constexpr (GATHER) {
        for (int u_ = 0; u_ < 16; ++u_) { Unit uu_ = {0, 0, 0, 0, 0}; if (!S.next(u_, uu_)) break; if (tid < 256) ridx[u_ * 256 + tid] = (unsigned short)g.rowidx[(size_t)uu_.pm * BM + tid]; }
        __syncthreads();
    }
    f32x4 acc[2][2][4][2];
    if constexpr (!SP2)
#pragma unroll
    for (int a = 0; a < 2; ++a)
#pragma unroll
        for (int b = 0; b < 2; ++b)
#pragma unroll
            for (int m = 0; m < 4; ++m)
#pragma unroll
                for (int n = 0; n < 2; ++n) acc[a][b][m][n] = (f32x4){0.f, 0.f, 0.f, 0.f};
    bf16x8 At[4][2], B0[2][2], B1[2][2];
    const char* cA = (const char*)g.A + (GATHER ? (size_t)0 : (size_t)cur.pm * tstep + ((cur.flags & 2) ? hstep : (size_t)0)) + (size_t)cur.kofs * kstep; const char* cB = (const char*)g.Bt + (size_t)cur.pn * tstep + (size_t)cur.kofs * kstep;
    S.a_ready(cur);
    if constexpr (SP2) {
        if (GATHER) PG8_GOFF(oc0, oc1, cur, 0);
        PG8_STAGE(PG8_SB(0, 0), cB, voffB); PG8_STAGE(PG8_SB(0, 1), cB + hstep, voffB); PG8_STAGE(PG8_SA(0, 0), cA, (GATHER ? oc0 : voffA)); PG8_STAGE(PG8_SA(0, 1), cA + hA, (GATHER ? oc1 : voffA));
        if (wr == 1) PG8_BAR;
        PG8_WAIT_V(2); PG8_BAR;
        PG8_STAGE(PG8_SB(1, 0), cB + kstep, voffB); PG8_STAGE(PG8_SA(1, 0), cA + kstep, (GATHER ? oc0 : voffA)); PG8_STAGE(PG8_SB(1, 1), cB + hstep + kstep, voffB);
        PG8_WAIT_V(6); PG8_BAR;
    } else {
        PG8_STAGE(PG8_SB(0, 0), cB, voffB); PG8_STAGE(PG8_SA(0, 0), cA, voffA); PG8_STAGE(PG8_SB(0, 1), cB + hstep, voffB); PG8_STAGE(PG8_SA(0, 1), cA + hstep, voffA);
        if (wr == 1) PG8_BAR;
        PG8_WAIT_V(4); PG8_BAR;
        PG8_STAGE(PG8_SB(1, 0), cB + kstep, voffB); PG8_STAGE(PG8_SA(1, 0), cA + kstep, voffA); PG8_STAGE(PG8_SB(1, 1), cB + hstep + kstep, voffB);
        PG8_WAIT_V(6); PG8_BAR;
    }
    for (;;) {
        nxt = (Unit){0, 0, 0, 0, 0};
        const bool has_next = S.next(ui + 1, nxt); const bool full_m = !(cur.flags & 1);
        const char* nA = has_next ? (const char*)g.A + (GATHER ? (size_t)0 : (size_t)nxt.pm * tstep + ((nxt.flags & 2) ? hstep : (size_t)0)) + (size_t)nxt.kofs * kstep : cA; const char* nB = has_next ? (const char*)g.Bt + (size_t)nxt.pn * tstep + (size_t)nxt.kofs * kstep : cB;
        for (int t = 0; t < nt; t += 2) {
            const bool last = (t == nt - 2);
            const char* a1 = cA + (size_t)(t + 1) * kstep;
            const char* a2 = last ? nA : cA + (size_t)(t + 2) * kstep; const char* b2 = last ? nB : cB + (size_t)(t + 2) * kstep;
            const char* a3 = a2 + kstep; const char* b3 = b2 + kstep;
            if (last && has_next) S.a_ready(nxt);
            if (GATHER) { if (last && has_next) PG8_GOFF(on0, on1, nxt, ui + 1); }
            unsigned s0[2], s1[2];
#pragma unroll
            for (int _i = 0; _i < 2; ++_i) { s0[_i] = GATHER ? ((last && has_next) ? on0[_i] : oc0[_i]) : voffA[_i]; s1[_i] = GATHER ? ((last && has_next) ? on1[_i] : oc1[_i]) : voffA[_i]; }
            if constexpr (SP2) {
            PG8_LDB(B0, 0, 0); PG8_LDB(B1, 0, 1); PG8_SCHED; PG8_LDA(At, 0, 0); PG8_STAGE(PG8_SA(1, 1), a1 + hA, (GATHER ? oc1 : voffA));
            PG8_WAIT_V(8); PG8_WAIT_L(0); PG8_BAR; PG8_MMA0(0, 0, At, B0); PG8_MMA0(0, 1, At, B1); PG8_BAR; PG8_SCHED;
            PG8_LDA(At, 0, 1); PG8_STAGE(PG8_SB(0, 0), b2, voffB); PG8_STAGE(PG8_SB(0, 1), b2 + hstep, voffB); PG8_STAGE(PG8_SA(0, 0), a2, s0);
            PG8_WAIT_V(8); PG8_WAIT_L(0); PG8_BAR; if (full_m) { PG8_MMA0(1, 0, At, B0); PG8_MMA0(1, 1, At, B1); } PG8_BAR; PG8_SCHED;
            PG8_LDB(B0, 1, 0); PG8_LDB(B1, 1, 1); PG8_SCHED; PG8_LDA(At, 1, 0); PG8_STAGE(PG8_SA(0, 1), a2 + hA, s1);
            PG8_WAIT_V(8); PG8_WAIT_L(0); PG8_BAR; PG8_MMA(0, 0, At, B0); PG8_MMA(0, 1, At, B1); PG8_BAR; PG8_SCHED;
            PG8_LDA(At, 1, 1); PG8_STAGE(PG8_SB(1, 0), b3, voffB); PG8_STAGE(PG8_SB(1, 1), b3 + hstep, voffB); PG8_STAGE(PG8_SA(1, 0), a3, s0);
            PG8_WAIT_V(8); PG8_WAIT_L(0); PG8_BAR; if (full_m) { PG8_MMA(1, 0, At, B0); PG8_MMA(1, 1, At, B1); } PG8_BAR; PG8_SCHED;
            } else {
            PG8_LDB(B0, 0, 0); PG8_SCHED; PG8_LDA(At, 0, 0); PG8_STAGE(PG8_SA(1, 1), a1 + hstep, voffA);
            PG8_WAIT_L(8); PG8_BAR; PG8_WAIT_L(0); PG8_MMA(0, 0, At, B0); PG8_BAR; PG8_SCHED;
            PG8_LDB(B1, 0, 1); PG8_STAGE(PG8_SB(0, 0), b2, voffB);
            PG8_BAR; PG8_WAIT_L(0); PG8_MMA(0, 1, At, B1); PG8_BAR;
            PG8_LDA(At, 0, 1); PG8_STAGE(PG8_SA(0, 0), a2, voffA);
            PG8_BAR; PG8_WAIT_L(0); PG8_MMA(1, 0, At, B0); PG8_BAR; PG8_SCHED;
            PG8_STAGE(PG8_SB(0, 1), b2 + hstep, voffB);
            PG8_WAIT_V(6); PG8_BAR; PG8_MMA(1, 1, At, B1); PG8_BAR;
            PG8_LDB(B0, 1, 0); PG8_SCHED; PG8_LDA(At, 1, 0); PG8_STAGE(PG8_SA(0, 1), a2 + hstep, voffA);
            PG8_WAIT_L(8); PG8_BAR; PG8_WAIT_L(0); PG8_MMA(0, 0, At, B0); PG8_BAR; PG8_SCHED;
            PG8_LDB(B1, 1, 1); PG8_STAGE(PG8_SB(1, 0), b3, voffB);
            PG8_BAR; PG8_WAIT_L(0); PG8_MMA(0, 1, At, B1); PG8_BAR;
            PG8_LDA(At, 1, 1); PG8_STAGE(PG8_SA(1, 0), a3, voffA);
            PG8_BAR; PG8_WAIT_L(0); PG8_MMA(1, 0, At, B0); PG8_BAR; PG8_SCHED;
            PG8_STAGE(PG8_SB(1, 1), b3 + hstep, voffB);
            PG8_WAIT_V(6); PG8_BAR; PG8_MMA(1, 1, At, B1); PG8_BAR;
            }
        }
        if constexpr (ALIGN_EPI) { if (wr == 0) PG8_BAR; }
        if constexpr (!Epi::AFTER_DRAIN) { E(acc, cur, wr, wc, fr, fq); S.done(cur); }
        if (!has_next) break;
        if constexpr (!SP2)
#pragma unroll
        for (int a = 0; a < 2; ++a)
#pragma unroll
            for (int b = 0; b < 2; ++b)
#pragma unroll
                for (int m = 0; m < 4; ++m)
#pragma unroll
                    for (int n = 0; n < 2; ++n) acc[a][b][m][n] = (f32x4){0.f, 0.f, 0.f, 0.f};
        cur = nxt; cA = nA; cB = nB; ++ui; nt = cur.nt ? cur.nt : K / BK;
        if (GATHER) {
#pragma unroll
            for (int _i = 0; _i < 2; ++_i) { oc0[_i] = on0[_i]; oc1[_i] = on1[_i]; } }
        if constexpr (ALIGN_EPI) { if (wr == 1) PG8_BAR; }
    }
    PG8_WAIT_V(0);
    if constexpr (!ALIGN_EPI) { if (wr == 0) PG8_BAR; }
    PG8_BAR;
    if constexpr (Epi::AFTER_DRAIN) { E.fused(acc, cur, wr, wc, fr, fq, lds, wid, lane); S.done(cur); }
#undef PG8_GOFF
#undef PG8_SA
#undef PG8_SB
#undef PG8_STAGE
#undef PG8_LDA
#undef PG8_LDB
#undef PG8_MMA
#undef PG8_MMA_
#undef PG8_MMA0
#undef PG8_WAIT_V
#undef PG8_WAIT_L
#undef PG8_BAR
#undef PG8_SCHED
}
}
#define GAS __attribute__((address_space(1)))
constexpr int DM = 1024, NB = 2, TL = 8192, TCX = 256;
constexpr int RL = NB * TL, RC = NB * TCX, RT = RL + RC;
constexpr int NH = 8;
constexpr int NE = 16, FE = 2816, CAPL = 1024, CAPC = 32, MROWS = 2304, MTE = 9;
constexpr int NCH = 132;
constexpr float EPS = 1e-6f;
constexpr int NWAVES = 8, NPH = 21;
constexpr float LAM_INIT = 0.35550906759f;
constexpr float QSCALE = 0.125f * 1.4426950408889634f;

typedef unsigned short bf16;
typedef short bf16x8 __attribute__((ext_vector_type(8)));
typedef short s16x4 __attribute__((ext_vector_type(4)));
typedef float f32x4 __attribute__((ext_vector_type(4)));
typedef float f32x2 __attribute__((ext_vector_type(2)));
typedef float f32x16 __attribute__((ext_vector_type(16)));
typedef unsigned u32x4 __attribute__((ext_vector_type(4)));
typedef unsigned u32x2 __attribute__((ext_vector_type(2)));
#define LAS __attribute__((address_space(3)))

constexpr size_t MiB = 1u << 20;
constexpr size_t WS_CTL = 0, CTL_ZERO_BYTES = 1 * MiB;
constexpr size_t WS_TAB = 1 * MiB;
constexpr size_t TAB_MOD = 0, TAB_LB = 163840, TAB_LAM = 172032, TAB_ROPE = 176128;
constexpr size_t WS_WHIN = 2 * MiB, WS_WHOUT = 12 * MiB, WS_WDIN = 14 * MiB, WS_WDOUT = 20 * MiB;
constexpr size_t WS_AFF = 22 * MiB, WS_SLOT = 24 * MiB, WS_IDX = 26 * MiB;
constexpr size_t WS_XA = 28 * MiB, WS_XB = 94 * MiB, WS_H = 160 * MiB, WS_OMIX = 193 * MiB;
constexpr size_t WS_WGU0 = 226 * MiB, WS_WDN0 = 402 * MiB, WS_WGU1 = 490 * MiB, WS_WDN1 = 666 * MiB;
constexpr size_t WS_ARENA = 754 * MiB;
constexpr size_t WS_Q = WS_ARENA, WS_LFF = WS_Q + 33 * MiB, WS_LFB = WS_LFF + 66 * MiB, WS_V = WS_LFB + 66 * MiB, WS_SG = WS_V + 33 * MiB;
constexpr size_t WS_P = WS_SG + 33 * MiB, WS_SS = WS_P + 264 * MiB, WS_DD = WS_SS + 132 * MiB, WS_HG_END = WS_DD + 3 * MiB;
constexpr size_t WS_XS = WS_ARENA, WS_ACT = WS_XS + 72 * MiB, WS_Y = WS_ACT + 198 * MiB, WS_Y2 = WS_Y + 72 * MiB, WS_MOE_END = WS_Y2 + 72 * MiB;
constexpr size_t WS_QA = WS_ARENA, WS_KA = WS_QA + 32 * MiB, WS_VA = WS_KA + 33 * MiB, WS_ON = WS_VA + 33 * MiB, WS_AT_END = WS_ON + 128 * MiB;
constexpr size_t WS_END = WS_HG_END;
static_assert(WS_HG_END >= WS_MOE_END && WS_HG_END >= WS_AT_END, "arena");
static_assert((size_t)RT * DM * 4 == 66 * MiB && (size_t)RT * DM * 2 == 33 * MiB, "sizes");
static_assert((size_t)NE * 5632 * 1024 * 2 == 176 * MiB && (size_t)NE * 1024 * FE * 2 == 88 * MiB, "sizes");
static_assert((size_t)NE * MROWS * FE * 2 == 198 * MiB && (size_t)NE * MROWS * DM * 2 == 72 * MiB, "sizes");
static_assert((size_t)32 * NCH * 128 * 128 * 4 == 264 * MiB, "sizes");
constexpr int CW_BAR = 4096, CW_ERR = 16384, CW_KMX = 20480, CW_QCTR = 21504, CW_DONE = 24576;

constexpr int LDS_BYTES = 147456, MISC_OFF = 140000;

__device__ __forceinline__ float bf2f(unsigned short b) { return __uint_as_float(((unsigned)b) << 16); }
__device__ __forceinline__ unsigned f2bf(float f) { unsigned u = __float_as_uint(f); return (u + 0x7fffu + ((u >> 16) & 1u)) >> 16; }
typedef float f32x2c_t __attribute__((ext_vector_type(2))); typedef __bf16 bf16x2c_t __attribute__((ext_vector_type(2)));
__device__ __forceinline__ unsigned cvtpk_mf(float lo, float hi) { const f32x2c_t v = {lo, hi}; const bf16x2c_t c = __builtin_convertvector(v, bf16x2c_t); return __builtin_bit_cast(unsigned, c); }
__device__ __forceinline__ float wave_sum(float v) {
#define WS_DPP(x, ctrl, rmask) __builtin_bit_cast(float, __builtin_amdgcn_update_dpp(0, __builtin_bit_cast(int, x), ctrl, rmask, 0xf, false))
    v += WS_DPP(v, 0xB1, 0xf);
    v += WS_DPP(v, 0x4E, 0xf);
    v += WS_DPP(v, 0x141, 0xf);
    v += WS_DPP(v, 0x140, 0xf);
    v += WS_DPP(v, 0x142, 0xa);
    v += WS_DPP(v, 0x143, 0xc);
#undef WS_DPP
    return __builtin_bit_cast(float, __builtin_amdgcn_readlane(__builtin_bit_cast(int, v), 63));
}
__device__ __forceinline__ float silu_f(float x) { return x / (1.f + __expf(-x)); }
__device__ __forceinline__ int crow(int r, int hi) { return (r & 3) + 8 * (r >> 2) + 4 * hi; }
#define KSWZ(row, colB) ((row) * 256 + ((colB) ^ (((row) & 7) << 4)))
#define KSWZ64(row, colB) ((row) * 128 + ((colB) ^ ((((row) >> 1) & 7) << 4)))
#define SBAR() __builtin_amdgcn_sched_barrier(0)
#define LDS_WAIT() asm volatile("s_waitcnt lgkmcnt(0)" ::: "memory")
#define VM_WAIT() asm volatile("s_waitcnt vmcnt(0)" ::: "memory")

__device__ __forceinline__ int v_st(int k, int c) { const int kk = (k & ~0xC) | ((k & 4) << 1) | ((k & 8) >> 1); return ((kk >> 3) * 4 + (c >> 5)) * 512 + ((kk & 7) * 32 + (c & 31)) * 2; }
__device__ __forceinline__ int v_rd_base(int lane) { return ((lane & 3) << 3) | (((lane >> 2) & 3) << 6) | (((lane >> 4) & 1) << 5) | (((lane >> 5) & 1) << 8); }
constexpr int v_rd_off(int d0, int ks, int half) { return d0 * 512 + ks * 4096 + half * 2048; }
template <int OFF> __device__ __forceinline__ s16x4 tr_read(int vb) {
    s16x4 r; asm volatile("ds_read_b64_tr_b16 %0, %1 offset:%2" : "=&v"(r) : "v"(vb), "i"(OFF) : "memory"); return r;
}
__device__ __forceinline__ void pvb(f32x16& od, int vb, bf16x8 pa0, bf16x8 pa1, bf16x8 pa2, bf16x8 pa3) {
    const s16x4 l0 = tr_read<v_rd_off(0, 0, 0)>(vb), h0 = tr_read<v_rd_off(0, 0, 1)>(vb), l1 = tr_read<v_rd_off(0, 1, 0)>(vb), h1 = tr_read<v_rd_off(0, 1, 1)>(vb);
    const s16x4 l2 = tr_read<v_rd_off(0, 2, 0)>(vb), h2 = tr_read<v_rd_off(0, 2, 1)>(vb), l3 = tr_read<v_rd_off(0, 3, 0)>(vb), h3 = tr_read<v_rd_off(0, 3, 1)>(vb);
    asm volatile("s_waitcnt lgkmcnt(0)" ::: "memory"); SBAR();
#define PKV(L, H) (bf16x8){L[0], L[1], L[2], L[3], H[0], H[1], H[2], H[3]}
    od = __builtin_amdgcn_mfma_f32_32x32x16_bf16(pa0, PKV(l0, h0), od, 0, 0, 0);
    od = __builtin_amdgcn_mfma_f32_32x32x16_bf16(pa1, PKV(l1, h1), od, 0, 0, 0);
    od = __builtin_amdgcn_mfma_f32_32x32x16_bf16(pa2, PKV(l2, h2), od, 0, 0, 0);
    od = __builtin_amdgcn_mfma_f32_32x32x16_bf16(pa3, PKV(l3, h3), od, 0, 0, 0);
#undef PKV
}
__device__ __forceinline__ unsigned cvtpk(float lo, float hi) { unsigned r; asm volatile("v_cvt_pk_bf16_f32 %0, %1, %2" : "=v"(r) : "v"(lo), "v"(hi)); return r; }
#define PK4(P, BASE, OUT) do { unsigned a0_ = cvtpk_mf(P[BASE + 0], P[BASE + 1]), a1_ = cvtpk_mf(P[BASE + 2], P[BASE + 3]);   \
    unsigned b0_ = cvtpk_mf(P[BASE + 4], P[BASE + 5]), b1_ = cvtpk_mf(P[BASE + 6], P[BASE + 7]);                              \
    auto r0_ = __builtin_amdgcn_permlane32_swap(a0_, b0_, false, false); auto r1_ = __builtin_amdgcn_permlane32_swap(a1_, b1_, false, false); \
    u32x4 w_ = {r0_[0], r1_[0], r0_[1], r1_[1]}; OUT = *reinterpret_cast<bf16x8*>(&w_); } while (0)
#define PK4A(P, BASE, OUT) do { unsigned a0_ = cvtpk(P[BASE + 0], P[BASE + 1]), a1_ = cvtpk(P[BASE + 2], P[BASE + 3]);   \
    unsigned b0_ = cvtpk(P[BASE + 4], P[BASE + 5]), b1_ = cvtpk(P[BASE + 6], P[BASE + 7]);                              \
    auto r0_ = __builtin_amdgcn_permlane32_swap(a0_, b0_, false, false); auto r1_ = __builtin_amdgcn_permlane32_swap(a1_, b1_, false, false); \
    u32x4 w_ = {r0_[0], r1_[0], r0_[1], r1_[1]}; OUT = *reinterpret_cast<bf16x8*>(&w_); } while (0)

struct Args { const float* in[21]; float* out; unsigned char* ws; int ph_lo, ph_hi; };
#define XB_TMO      128
#define XB_XCNT(j)  (256  + 64 * (j))
#define XB_XSUB(j)  (1280 + 64 * (j))
#define XB_XGEN(j)  (2304 + 64 * (j))
#define XB_TOP      3328
#define XB_TOPGEN   3392
#define XCD_BAR_WORDS 3456
#define XB_SPIN_CAP (1u << 18)

__device__ __forceinline__ unsigned xb_ld(unsigned* p)              { return __hip_atomic_load(p, __ATOMIC_RELAXED, __HIP_MEMORY_SCOPE_AGENT); }
__device__ __forceinline__ unsigned xb_add(unsigned* p, unsigned v) { return __hip_atomic_fetch_add(p, v, __ATOMIC_RELAXED, __HIP_MEMORY_SCOPE_AGENT); }
__device__ __forceinline__ unsigned xb_xcc_id() { return (unsigned)__builtin_amdgcn_s_getreg((3 << 11) | 20) & 0xFu; }
#define XB_SPIN(cond, bar) do { unsigned _sp = 0; while (cond) { __builtin_amdgcn_s_sleep(1); \
    if ((++_sp & 255u) == 0u) { if (xb_ld(&(bar)[XB_TMO])) break; if (_sp > XB_SPIN_CAP) { atomicAdd(&(bar)[XB_TMO], 1u); break; } } } } while (0)

struct XcdBarrier {
    unsigned* bar; unsigned x;
    volatile LAS unsigned* st;
};

__device__ __forceinline__ XcdBarrier xcd_barrier_post(unsigned* bar, volatile LAS unsigned* st) {
    XcdBarrier b; b.bar = bar; b.x = xb_xcc_id(); b.st = st;
    if (threadIdx.x == 0) (void)xb_add(&bar[XB_XCNT(b.x)], 1u);
    return b;
}
__device__ __forceinline__ void xcd_barrier_complete(unsigned* bar, unsigned x, unsigned& nloc, unsigned& nx) {
    const unsigned G = gridDim.x * gridDim.y * gridDim.z;
    unsigned sum, cnt, mine, sp = 0u;
    for (;;) {
        sum = 0u; cnt = 0u; mine = 0u;
#pragma unroll
        for (unsigned j = 0; j < 16; ++j) { const unsigned c = xb_ld(&bar[XB_XCNT(j)]); sum += c; cnt += (c > 0u) ? 1u : 0u; mine = (j == x) ? c : mine; }
        if (sum == G) break;
        __builtin_amdgcn_s_sleep(1);
        if ((++sp & 255u) == 0u) { if (xb_ld(&bar[XB_TMO])) break; if (sp > XB_SPIN_CAP) { atomicAdd(&bar[XB_TMO], 1u); break; } }
    }
    nloc = mine > 0u ? mine : 1u; nx = cnt > 0u ? cnt : 1u;
}

__device__ __forceinline__ void xcd_barrier(const XcdBarrier& b) {
    asm volatile("s_waitcnt vmcnt(0)" ::: "memory");
    __syncthreads();
    if (threadIdx.x == 0) {
        unsigned* bar = b.bar;
        __builtin_amdgcn_s_waitcnt(0);
        unsigned nloc = b.st[0], nx = b.st[1];
        if (nloc == 0u) { xcd_barrier_complete(bar, b.x, nloc, nx); b.st[0] = nloc; b.st[1] = nx; }
        const unsigned old = xb_add(&bar[XB_XSUB(b.x)], 1u);
        const unsigned gen = old / nloc;
        if (old + 1u == (gen + 1u) * nloc) {
            __builtin_amdgcn_fence(__ATOMIC_RELEASE, "agent");
            asm volatile("s_waitcnt vmcnt(0)" ::: "memory");
            const unsigned og = xb_add(&bar[XB_TOP], 1u);
            const unsigned tg = og / nx;
            if (og + 1u == (tg + 1u) * nx) xb_add(&bar[XB_TOPGEN], 1u);
            else XB_SPIN(xb_ld(&bar[XB_TOPGEN]) == tg, bar);
            __builtin_amdgcn_fence(__ATOMIC_ACQUIRE, "agent");
            xb_add(&bar[XB_XGEN(b.x)], 1u);
            asm volatile("s_waitcnt vmcnt(0)" ::: "memory");
        } else {
            XB_SPIN(xb_ld(&bar[XB_XGEN(b.x)]) == gen, bar);
            __builtin_amdgcn_fence(__ATOMIC_ACQUIRE, "agent");
            asm volatile("s_waitcnt vmcnt(0)" ::: "memory");
        }
    }
    __syncthreads();
}
namespace pg8 {
struct TailOrder {
    StaticOrder S0; int nmain, ntail, tm0, tn0, tnn, G, c;
    __device__ __forceinline__ void init(int nM, int nN, int G_, int c_, int tm0_, int tn0_, int tmm, int tnn_) { S0.init(nM * BM, nN * BM, G_, c_); nmain = nM * nN; tm0 = tm0_; tn0 = tn0_; tnn = tnn_; ntail = tmm * tnn_ * 2; G = G_; c = c_; }
    __device__ __forceinline__ bool next(int i, Unit& u) const {
        const long L = (long)i * G + c; if (L >= nmain + ntail) return false;
        const bool tl = L >= nmain;
        Unit m = {0, 0, 0, 0, 0}; (void)S0.next(tl ? 0 : i, m);
        const int idx = tl ? (int)(L - nmain) : 0, hf = idx & 1, t = idx >> 1;
        const int pm = tl ? tm0 + t / tnn : m.pm, pn = tl ? tn0 + t % tnn : m.pn, fl = tl ? (1 | (hf << 1)) : 0;
        u.pm = pm; u.pn = pn; u.nt = 0; u.kofs = 0; u.flags = fl;
        return true;
    }
    __device__ __forceinline__ void a_ready(const Unit&) const {}
    __device__ __forceinline__ void done(const Unit&) const {}
};
struct GroupedOrder {
    int G, c, nNt, nmain, ntail, ks, knt;
    __device__ __forceinline__ void init(int nNt_, int G_, int c_, bool tail, int ks_, int ktiles) { nNt = nNt_; G = G_; c = c_; nmain = NE * 8 * nNt_; ks = ks_; knt = ktiles / ks_; ntail = tail ? NE * nNt_ * ks_ : 0; }
    __device__ __forceinline__ bool next(int i, Unit& u) const {
        const long L = (long)i * G + c; if (L >= nmain + ntail) return false;
        const bool tl = L >= nmain;
        int wgid = (int)L; { const int q = nmain / NXCD, r = nmain % NXCD, xcd = wgid % NXCD, off = wgid / NXCD; wgid = (xcd < r ? xcd * (q + 1) : r * (q + 1) + (xcd - r) * q) + off; }
        const int nig = 8 * nNt, e_m = wgid / nig, w = wgid % nig;
        const int idx = (int)(L - nmain), sl = idx % ks, t = idx / ks, e_t = t / nNt;
        const int pm = tl ? e_t * MTE + 8 : e_m * MTE + (w % 8), pn = tl ? e_t * nNt + t % nNt : e_m * nNt + (w / 8);
        const int unt = (tl && ks > 1) ? knt : 0, uko = (tl && ks > 1) ? sl * knt : 0, ufl = tl ? 1 : 0;
        u.pm = pm; u.pn = pn; u.nt = unt; u.kofs = uko; u.flags = ufl;
        return true;
    }
    __device__ __forceinline__ void a_ready(const Unit&) const {}
    __device__ __forceinline__ void done(const Unit&) const {}
};

__device__ __forceinline__ u32x4 pack8(const f32x4 a, const f32x4 b) { u32x4 w; w.x = cvt_pk_bf16(a[0], a[1]); w.y = cvt_pk_bf16(a[2], a[3]); w.z = cvt_pk_bf16(b[0], b[1]); w.w = cvt_pk_bf16(b[2], b[3]); return w; }
__device__ __forceinline__ f32x4 silu4(const f32x4 x) { f32x4 r; for (int j = 0; j < 4; ++j) r[j] = x[j] * __builtin_amdgcn_rcpf(1.f + __expf(-x[j])); return r; }

struct EpiHin {
    static constexpr bool PERM = true, AFTER_DRAIN = false;
    bf16_t* Q; bf16_t* LFF; bf16_t* LFB; bf16_t* V; bf16_t* SG; const float* LB;
    __device__ __forceinline__ void operator()(const f32x4 (&acc)[2][2][4][2], const Unit& u, int wr, int wc, int fr, int fq) const {
        const int sec = u.pn >> 2, colt = (u.pn & 3) * BM, row0 = u.pm * BM + ((u.flags & 2) ? HALF : 0) + wr * 64 + fr;
#pragma unroll
        for (int ai = 0; ai < 2; ++ai) { if (ai == 1 && (u.flags & 1)) continue;
#pragma unroll
            for (int m = 0; m < 4; ++m) { const size_t roff = (size_t)(row0 + ai * HALF + m * 16) * 1024;
#pragma unroll
                for (int bj = 0; bj < 2; ++bj) { const int col0 = colt + bj * HALF + wc * 32 + 8 * fq; const f32x4 v0 = acc[ai][bj][m][0], v1 = acc[ai][bj][m][1];
                    if (sec == 0)      *(u32x4*)(Q + roff + col0) = pack8(silu4(v0), silu4(v1));
                    else if (sec == 4) *(u32x4*)(SG + roff + col0) = pack8(silu4(v0), silu4(v1));
                    else if (sec == 3) *(u32x4*)(V + roff + col0) = pack8(v0, v1);
                    else { const f32x4 l0 = *(const f32x4*)(LB + col0), l1 = *(const f32x4*)(LB + col0 + 4); f32x4 o0, o1;
#pragma unroll
                        for (int j = 0; j < 4; ++j) { o0[j] = __builtin_amdgcn_logf(l0[j] + (1.f - l0[j]) * __builtin_amdgcn_rcpf(1.f + __expf(-v0[j]))); o1[j] = __builtin_amdgcn_logf(l1[j] + (1.f - l1[j]) * __builtin_amdgcn_rcpf(1.f + __expf(-v1[j]))); }
                        *(u32x4*)((sec == 1 ? LFF : LFB) + roff + col0) = pack8(o0, o1); } } } }
    }
};
struct EpiResid {
    static constexpr bool PERM = false, AFTER_DRAIN = false;
    const float* xlat; const float* xctx; const float* gate; float* out;
    __device__ __forceinline__ void operator()(const f32x4 (&acc)[2][2][4][2], const Unit& u, int wr, int wc, int fr, int fq) const {
        const int row0 = u.pm * BM + ((u.flags & 2) ? HALF : 0) + wr * 64 + fr, col0 = u.pn * BM + wc * 32 + 4 * fq;
#pragma unroll
        for (int ai = 0; ai < 2; ++ai) { if (ai == 1 && (u.flags & 1)) continue;
#pragma unroll
            for (int m = 0; m < 4; ++m) { const int row = row0 + ai * HALF + m * 16; const int rc = row < TL ? 0 : (row < RL ? 1 : 2);
                const float* src = row < RL ? xlat + (size_t)row * 1024 : xctx + (size_t)(row - RL) * 1024; const float* gp = gate + rc * 6144; float* dst = out + (size_t)row * 1024;
#pragma unroll
                for (int bj = 0; bj < 2; ++bj)
#pragma unroll
                    for (int n = 0; n < 2; ++n) { const int c = col0 + bj * HALF + n * 16; const f32x4 x = *(const f32x4*)(src + c), g = *(const f32x4*)(gp + c); *(f32x4*)(dst + c) = x + g * acc[ai][bj][m][n]; } } }
    }
};
__device__ __forceinline__ f32x4 silu4_l2(const f32x4 x) { f32x4 r; for (int j = 0; j < 4; ++j) r[j] = x[j] * __builtin_amdgcn_rcpf(1.f + __builtin_amdgcn_exp2f(-x[j])); return r; }
struct EpiMoe1 {
    static constexpr bool PERM = true, AFTER_DRAIN = false;
    bf16_t* ACT;
    __device__ __forceinline__ void operator()(const f32x4 (&acc)[2][2][4][2], const Unit& u, int wr, int wc, int fr, int fq) const {
        const int nt = u.pn % 22, row0 = u.pm * BM + wr * 64 + fr, col0 = nt * 128 + wc * 32 + 8 * fq;
#pragma unroll
        for (int ai = 0; ai < 2; ++ai) { if (ai == 1 && (u.flags & 1)) continue;
#pragma unroll
            for (int m = 0; m < 4; ++m) { const size_t roff = (size_t)(row0 + ai * HALF + m * 16) * FE;
                const f32x4 a0 = silu4_l2(acc[ai][0][m][0]) * acc[ai][1][m][0], a1 = silu4_l2(acc[ai][0][m][1]) * acc[ai][1][m][1];
                *(u32x4*)(ACT + roff + col0) = pack8(a0, a1); } }
    }
};
struct EpiMoe2 {
    static constexpr bool PERM = true, AFTER_DRAIN = false;
    bf16_t* Y; bf16_t* Y2;
    __device__ __forceinline__ void operator()(const f32x4 (&acc)[2][2][4][2], const Unit& u, int wr, int wc, int fr, int fq) const {
        const int nt = u.pn & 3, row0 = u.pm * BM + wr * 64 + fr, col0 = nt * BM + wc * 32 + 8 * fq; bf16_t* dst = u.kofs ? Y2 : Y;
#pragma unroll
        for (int ai = 0; ai < 2; ++ai) { if (ai == 1 && (u.flags & 1)) continue;
#pragma unroll
            for (int m = 0; m < 4; ++m) { const size_t roff = (size_t)(row0 + ai * HALF + m * 16) * 1024;
#pragma unroll
                for (int bj = 0; bj < 2; ++bj) *(u32x4*)(dst + roff + col0 + bj * HALF) = pack8(acc[ai][bj][m][0], acc[ai][bj][m][1]); } }
    }
};
struct EpiDin {
    static constexpr bool PERM = true, AFTER_DRAIN = false;
    bf16_t* QA; bf16_t* KA; bf16_t* VA; const float* rope;
    unsigned* KMX;
    __device__ __forceinline__ void operator()(const f32x4 (&acc)[2][2][4][2], const Unit& u, int wr, int wc, int fr, int fq) const {
        const int sec = u.pn >> 2, colt = (u.pn & 3) * BM, row0 = u.pm * BM + ((u.flags & 2) ? HALF : 0) + wr * 64 + fr;
        float kmx[2] = {0.f, 0.f};
#pragma unroll
        for (int ai = 0; ai < 2; ++ai) { if (ai == 1 && (u.flags & 1)) continue;
#pragma unroll
            for (int m = 0; m < 4; ++m) { const int row = row0 + ai * HALF + m * 16; const size_t roff = (size_t)row * 1024; const int t = row & (TL - 1), rp = t >> 6, cp = t & 63;
#pragma unroll
                for (int bj = 0; bj < 2; ++bj) { const int col0 = colt + bj * HALF + wc * 32 + 8 * fq; f32x4 v0 = acc[ai][bj][m][0], v1 = acc[ai][bj][m][1];
                    if (sec == 2) { *(u32x4*)(VA + roff + col0) = pack8(v0, v1); continue; }
                    if (row < RL) { const int i0 = (col0 & 63) >> 1; const float* tb = (i0 < 16) ? rope + (size_t)(rp * 16 + i0) * 2 : rope + (size_t)((128 + cp) * 16 + (i0 - 16)) * 2;
                        const f32x4 cs0 = *(const f32x4*)tb, cs1 = *(const f32x4*)(tb + 4);
                        f32x4 o0, o1;
                        o0[0] = v0[0] * cs0[0] - v0[1] * cs0[1]; o0[1] = v0[1] * cs0[0] + v0[0] * cs0[1];
                        o0[2] = v0[2] * cs0[2] - v0[3] * cs0[3]; o0[3] = v0[3] * cs0[2] + v0[2] * cs0[3];
                        o1[0] = v1[0] * cs1[0] - v1[1] * cs1[1]; o1[1] = v1[1] * cs1[0] + v1[0] * cs1[1];
                        o1[2] = v1[2] * cs1[2] - v1[3] * cs1[3]; o1[3] = v1[3] * cs1[2] + v1[2] * cs1[3];
                        v0 = o0; v1 = o1; }
                    if (sec == 0) { v0 = v0 * QSCALE; v1 = v1 * QSCALE; *(u32x4*)(QA + roff + col0) = pack8(v0, v1); }
                    else { *(u32x4*)(KA + roff + col0) = pack8(v0, v1);
                        float s = (v0[0] * v0[0] + v0[1] * v0[1]) + (v0[2] * v0[2] + v0[3] * v0[3]) + (v1[0] * v1[0] + v1[1] * v1[1]) + (v1[2] * v1[2] + v1[3] * v1[3]);
                        s += __shfl_xor(s, 16); s += __shfl_xor(s, 32); kmx[bj] = fmaxf(kmx[bj], s); } } } }
        if (sec == 1) {
#pragma unroll
            for (int bj = 0; bj < 2; ++bj) { float s = kmx[bj]; s = fmaxf(s, __shfl_xor(s, 1)); s = fmaxf(s, __shfl_xor(s, 2)); s = fmaxf(s, __shfl_xor(s, 4)); s = fmaxf(s, __shfl_xor(s, 8));
                if (fr == 0 && fq == 0) atomicMax(KMX + (u.pm >= 64 ? u.pm - 64 : (u.pm >> 5)) * 32 + ((colt + bj * HALF + wc * 32) >> 5), __float_as_uint(s)); } }
    }
};
}
template <int MODE> __device__ __forceinline__ int tr_outrow(int row_off, int n) {
    if (MODE == 1) return row_off + (n >> 7) * 256 + (n & 127);
    if (MODE == 2) { if (n < 2048) { const int g = n >> 6, i = n & 63; return row_off + 64 * g + ((i & 31) << 1) + (i >> 5); } return row_off + n; }
    return row_off + n;
}
template <int MODE> __device__ __forceinline__ void tr_item(const float* __restrict__ W, int K, int N, bf16* __restrict__ WT, int row_off, LAS float* scr, int item, int lane) {
    const int nblk = N / 32, kb = item / nblk, nb = item % nblk, k0 = 64 * kb, n0 = 32 * nb;
#pragma unroll 8
    for (int i = 0; i < 32; ++i) { const int kk = 2 * i + (lane >> 5); scr[kk * 33 + (lane & 31)] = W[(size_t)(k0 + kk) * N + n0 + (lane & 31)]; }
    LDS_WAIT(); asm volatile("" ::: "memory");
    const int c = lane & 7;
#pragma unroll
    for (int j = 0; j < 4; ++j) { const int n = (lane >> 3) + 8 * j; const LAS float* s = scr + (8 * c) * 33 + n;
        u32x4 o; o.x = cvtpk(s[0 * 33], s[1 * 33]); o.y = cvtpk(s[2 * 33], s[3 * 33]); o.z = cvtpk(s[4 * 33], s[5 * 33]); o.w = cvtpk(s[6 * 33], s[7 * 33]);
        *(u32x4*)(WT + (size_t)tr_outrow<MODE>(row_off, n0 + n) * K + k0 + 8 * c) = o; }
    LDS_WAIT(); asm volatile("" ::: "memory");
}
__device__ __forceinline__ void p0_prologue(const Args& a, LAS unsigned char* lds, int vcu, int G) {
    const int tid = threadIdx.x, lane = tid & 63, wave = __builtin_amdgcn_readfirstlane(tid >> 6);
    unsigned char* ws = a.ws;
    float* TAB = (float*)(ws + WS_TAB);
    for (int task = vcu; task < 51; task += G) {
        if (task < 48) {
            LAS float* sv = (LAS float*)lds;
            LAS float* red = (LAS float*)(lds + 12288);
            const int layer = task / 24, cg = task % 24;
            for (int idx = tid; idx < 3072; idx += 512) { const int j = idx >> 10, k = idx & 1023; const float x = j < 2 ? a.in[1][j * 1024 + k] : a.in[3][k]; sv[idx] = x / (1.f + __expf(-x)); }
            __syncthreads();
            const float* W = a.in[4] + (size_t)layer * 1024 * 6144 + cg * 256 + 4 * lane;
            f32x4 a0 = {0.f, 0.f, 0.f, 0.f}, a1 = a0, a2 = a0;
#pragma unroll 8
            for (int kk = 0; kk < 128; ++kk) { const int k = wave * 128 + kk; const f32x4 w = *(const f32x4*)(W + (size_t)k * 6144);
                a0 += w * sv[k]; a1 += w * sv[1024 + k]; a2 += w * sv[2048 + k]; }
            *(LAS f32x4*)(red + (wave * 3 + 0) * 256 + 4 * lane) = a0; *(LAS f32x4*)(red + (wave * 3 + 1) * 256 + 4 * lane) = a1; *(LAS f32x4*)(red + (wave * 3 + 2) * 256 + 4 * lane) = a2;
            __syncthreads();
            for (int idx = tid; idx < 768; idx += 512) { const int j = idx >> 8, cc = idx & 255; float s = a.in[5][layer * 6144 + cg * 256 + cc];
#pragma unroll
                for (int w = 0; w < 8; ++w) s += red[(w * 3 + j) * 256 + cc];
                TAB[TAB_MOD / 4 + (layer * 3 + j) * 6144 + cg * 256 + cc] = s; }
            __syncthreads();
        } else if (task == 48) {
            for (int k = tid; k < 1024; k += 512) { const float l0 = a.in[10][k], l1 = a.in[10][1024 + k]; TAB[TAB_LB / 4 + k] = 1.f / (1.f + expf(l1 - l0)); }
        } else if (task == 49) {
            if (wave == 0) { const float* lv = a.in[14]; const float sa = wave_sum(lv[lane] * lv[64 + lane]), sb = wave_sum(lv[128 + lane] * lv[192 + lane]);
                if (lane == 0) { TAB[TAB_LAM / 4] = expf(sa) - expf(sb) + LAM_INIT; TAB[TAB_LAM / 4 + 1] = 1.f - LAM_INIT; } }
        } else {
            for (int idx = tid; idx < 192 * 16; idx += 512) { const int pos = idx >> 4, i = idx & 15; const int p = pos < 128 ? pos : pos - 128;
                const float freq = powf(10000.f, -(float)i / 16.f), ang = (float)p * freq; TAB[TAB_ROPE / 4 + idx * 2] = cosf(ang); TAB[TAB_ROPE / 4 + idx * 2 + 1] = sinf(ang); }
        }
    }
    __syncthreads();
    LAS float* scr = (LAS float*)(lds + wave * 16384);
    const int ntask = G > 102 ? 51 : 0;
    if (vcu < ntask) return;
    const int gw = (vcu - ntask) * NWAVES + wave, NGW = (G - ntask) * NWAVES;
    constexpr int I_HIN = 16 * 160, I_HOUT = 16 * 32, I_DIN = 16 * 96, I_DOUT = 16 * 32, NITEMS = I_HIN + I_HOUT + I_DIN + I_DOUT;
    for (int it = gw; it < NITEMS; it += NGW) {
        int r = it;
        if (r < I_HIN) { tr_item<0>(a.in[9], 1024, 5120, (bf16*)(ws + WS_WHIN), 0, scr, r, lane); continue; } r -= I_HIN;
        if (r < I_HOUT) { tr_item<0>(a.in[12], 1024, 1024, (bf16*)(ws + WS_WHOUT), 0, scr, r, lane); continue; } r -= I_HOUT;
        if (r < I_DIN) { tr_item<2>(a.in[13], 1024, 3072, (bf16*)(ws + WS_WDIN), 0, scr, r, lane); continue; } r -= I_DIN;
        tr_item<0>(a.in[16], 1024, 1024, (bf16*)(ws + WS_WDOUT), 0, scr, r, lane);
    }
}
constexpr int BG_PER_MAT = 1408, BG_PER_LAYER = 48 * BG_PER_MAT, BG_WAVE = 33;
static_assert(BG_WAVE * 8 * 256 == BG_PER_LAYER, "static deal assumes 256 workgroups of 8 waves");
struct TrDesc { const float* W; bf16* WT; int K, N, row_off, mode, item; float scl; };
__device__ __forceinline__ TrDesc bg_desc(const Args& a, int r) {
    unsigned char* ws = a.ws; TrDesc d;
    const int mat = r / BG_PER_MAT, rr = r % BG_PER_MAT, layer = mat / 48, e = (mat % 48) / 3, which = mat % 3;
    d.item = rr; d.mode = which < 2 ? 1 : 0; d.scl = which == 0 ? 1.44269504f : (which == 1 ? 0.693147181f : 1.f);
    if (which < 2) { d.W = (which ? a.in[19] : a.in[18]) + (size_t)(layer * NE + e) * 1024 * FE; d.K = 1024; d.N = FE; d.WT = (bf16*)(ws + (layer ? WS_WGU1 : WS_WGU0)); d.row_off = e * 5632 + which * 128; }
    else { d.W = a.in[20] + (size_t)(layer * NE + e) * FE * 1024; d.K = FE; d.N = 1024; d.WT = (bf16*)(ws + (layer ? WS_WDN1 : WS_WDN0)); d.row_off = e * 1024; }
    return d;
}
__device__ __forceinline__ void tr_load(const TrDesc& d, f32x4 (&r)[8], int lane) {
    const int nblk = d.N / 32, kb = d.item / nblk, nb = d.item % nblk, k0 = 64 * kb, n0 = 32 * nb;
    const float* p = d.W + (size_t)(k0 + (lane >> 3)) * d.N + n0 + 4 * (lane & 7);
#pragma unroll
    for (int i = 0; i < 8; ++i) r[i] = *(const f32x4*)(p + (size_t)(8 * i) * d.N);
}
__device__ __forceinline__ void tr_finish(const TrDesc& d, const f32x4 (&r)[8], LAS float* scr, int lane) {
    const int nblk = d.N / 32, kb = d.item / nblk, nb = d.item % nblk, k0 = 64 * kb, n0 = 32 * nb;
#pragma unroll
    for (int i = 0; i < 8; ++i) { LAS float* w = scr + (8 * i + (lane >> 3)) * 33 + 4 * (lane & 7); w[0] = r[i][0]; w[1] = r[i][1]; w[2] = r[i][2]; w[3] = r[i][3]; }
    LDS_WAIT(); asm volatile("" ::: "memory");
    const int c = lane & 7;
#pragma unroll
    for (int j = 0; j < 4; ++j) { const int n = (lane >> 3) + 8 * j; const LAS float* s = scr + (8 * c) * 33 + n;
        const float sc_ = d.scl;
        u32x4 o; o.x = cvtpk(s[0 * 33] * sc_, s[1 * 33] * sc_); o.y = cvtpk(s[2 * 33] * sc_, s[3 * 33] * sc_); o.z = cvtpk(s[4 * 33] * sc_, s[5 * 33] * sc_); o.w = cvtpk(s[6 * 33] * sc_, s[7 * 33] * sc_);
        const int orow = d.mode ? tr_outrow<1>(d.row_off, n0 + n) : tr_outrow<0>(d.row_off, n0 + n);
        *(u32x4*)(d.WT + (size_t)orow * d.K + k0 + 8 * c) = o; }
    LDS_WAIT(); asm volatile("" ::: "memory");
}
__device__ __forceinline__ void bg_convert(const Args& a, LAS unsigned char* lds, int target, unsigned* donep, int G) {
    const int tid = threadIdx.x, lane = tid & 63, wave = __builtin_amdgcn_readfirstlane(tid >> 6);
    volatile LAS unsigned* curp = (volatile LAS unsigned*)(lds + MISC_OFF) + 24 + wave;
    LAS float* scr = (LAS float*)(lds + wave * 16384);
    volatile LAS unsigned* stopf = (volatile LAS unsigned*)(lds + MISC_OFF) + 20;
    if (tid == 0) *stopf = 0u;
    __syncthreads();
    if (donep && tid == 0) __hip_atomic_fetch_add(donep, 1u, __ATOMIC_RELAXED, __HIP_MEMORY_SCOPE_AGENT);
    if (G != 256) { if (!donep) {
            for (int l = 0; l < target / BG_WAVE; ++l) for (int it = (int)blockIdx.x * NWAVES + wave; it < BG_PER_LAYER; it += G * NWAVES) { f32x4 rr_[8]; const TrDesc dd = bg_desc(a, l * BG_PER_LAYER + it); tr_load(dd, rr_, lane); tr_finish(dd, rr_, scr, lane); } }
        return; }
    const int gw = (int)blockIdx.x * NWAVES + wave;
    unsigned cur = *curp;
    if ((int)cur < target) {
        f32x4 r0[8], r1[8], r2[8], r3[8];
#define BG_ITEM_OF(cc) (((cc) >= (unsigned)BG_WAVE ? BG_PER_LAYER : 0) + ((int)(cc) - ((cc) >= (unsigned)BG_WAVE ? BG_WAVE : 0)) * (256 * NWAVES) + gw)
#define BG_LD(k, rr) do { if ((k) < rem) { const TrDesc d_ = bg_desc(a, BG_ITEM_OF(cur + (k))); tr_load(d_, rr, lane); } } while (0)
#define BG_FN(k, rr) do { const TrDesc d_ = bg_desc(a, BG_ITEM_OF(cur + (k))); tr_finish(d_, rr, scr, lane); } while (0)
        const int rem = target - (int)cur;
        BG_LD(0, r0); BG_LD(1, r1); BG_LD(2, r2);
        for (int k = 0; k < rem; k += 4) {
            BG_LD(k + 3, r3); BG_FN(k, r0);
            if (k + 1 >= rem) break;
            BG_LD(k + 4, r0); BG_FN(k + 1, r1);
            if (k + 2 >= rem) break;
            BG_LD(k + 5, r1); BG_FN(k + 2, r2);
            if (k + 3 >= rem) break;
            BG_LD(k + 6, r2); BG_FN(k + 3, r3);
        }
        cur += (unsigned)rem;
#undef BG_ITEM_OF
#undef BG_LD
#undef BG_FN
    }
    *curp = cur;
}

template <bool ROUTER> __device__ __forceinline__ void norm_phase(const float* xlat, const float* xctx, int nrows, const float* gw_, const float* mod, int sh_idx, int sc_idx,
                                                                  bf16* H, const float* wrt, float* AFF, LAS unsigned char* lds, int vcu, int G) {
    const int tid = threadIdx.x, lane = tid & 63, wave = __builtin_amdgcn_readfirstlane(tid >> 6);
    LAS float* wl = (LAS float*)lds;
    if (ROUTER) { for (int idx = tid; idx < 16384; idx += 512) { const int c = idx >> 4, e = idx & 15; wl[e * 1024 + c] = wrt[idx]; } __syncthreads(); }
    const int gwv = vcu * NWAVES + wave, NGW = G * NWAVES;
    f32x4 vn[4];
    if (gwv < nrows) { const float* s0 = gwv < RL ? xlat + (size_t)gwv * 1024 : xctx + (size_t)(gwv - RL) * 1024;
#pragma unroll
        for (int j = 0; j < 4; ++j) vn[j] = *(const f32x4*)(s0 + 4 * lane + 256 * j); }
    for (int row = gwv; row < nrows; row += NGW) {
        const int rc = row < TL ? 0 : (row < RL ? 1 : 2);
        f32x4 v[4]; float ss = 0.f;
#pragma unroll
        for (int j = 0; j < 4; ++j) { v[j] = vn[j]; ss += (v[j][0] * v[j][0] + v[j][1] * v[j][1]) + (v[j][2] * v[j][2] + v[j][3] * v[j][3]); }
        { const int nr = row + NGW; if (nr < nrows) { const float* s1 = nr < RL ? xlat + (size_t)nr * 1024 : xctx + (size_t)(nr - RL) * 1024;
#pragma unroll
            for (int j = 0; j < 4; ++j) vn[j] = *(const f32x4*)(s1 + 4 * lane + 256 * j); } }
        const float rstd = rsqrtf(wave_sum(ss) * (1.f / 1024.f) + EPS);
        const float* scp = mod + rc * 6144 + sc_idx * 1024; const float* shp = mod + rc * 6144 + sh_idx * 1024;
        f32x4 hv[4];
#pragma unroll
        for (int j = 0; j < 4; ++j) { const int c = 4 * lane + 256 * j; const f32x4 g = *(const f32x4*)(gw_ + c), sc = *(const f32x4*)(scp + c), sh = *(const f32x4*)(shp + c);
            hv[j] = v[j] * rstd * g * (sc + 1.f) + sh;
            u32x2 w; w.x = cvtpk(hv[j][0], hv[j][1]); w.y = cvtpk(hv[j][2], hv[j][3]); *(u32x2*)(H + (size_t)row * 1024 + c) = w; }
        if (ROUTER) {
            float lg[16];
#pragma unroll
            for (int e = 0; e < 16; ++e) { float s = 0.f;
#pragma unroll
                for (int j = 0; j < 4; ++j) { const f32x4 w = *(const LAS f32x4*)(wl + e * 1024 + 4 * lane + 256 * j); s += (hv[j][0] * w[0] + hv[j][1] * w[1]) + (hv[j][2] * w[2] + hv[j][3] * w[3]); }
                lg[e] = wave_sum(s); }
            float mx = lg[0];
#pragma unroll
            for (int e = 1; e < 16; ++e) mx = fmaxf(mx, lg[e]);
            float den = 0.f;
#pragma unroll
            for (int e = 0; e < 16; ++e) { lg[e] = expf(lg[e] - mx); den += lg[e]; }
            float mine = 0.f;
#pragma unroll
            for (int e = 0; e < 16; ++e) mine = (lane == e) ? lg[e] : mine;
            if (lane < 16) AFF[(size_t)row * 16 + lane] = mine / den;
        }
    }
}
template <bool FINAL> __device__ __forceinline__ void combine_phase(const float* XA, int nrows, const int* SLOT, const float* AFF, const bf16* Y, const bf16* Y2, const float* mod_cur  ,
                                                                    float* XB, const float* gnext, const float* mod_next, bf16* H, float* out, int vcu, int G) {
    const int tid = threadIdx.x, lane = tid & 63, wave = __builtin_amdgcn_readfirstlane(tid >> 6);
    const int gwv = vcu * NWAVES + wave, NGW = G * NWAVES;
    int sl_n = 0; float af_n = 0.f; f32x4 xn[4];
    if (gwv < nrows) { sl_n = SLOT[(size_t)gwv * 16 + (lane & 15)]; af_n = AFF[(size_t)gwv * 16 + (lane & 15)];
#pragma unroll
        for (int j = 0; j < 4; ++j) xn[j] = *(const f32x4*)(XA + (size_t)gwv * 1024 + 4 * lane + 256 * j); }
    for (int row = gwv; row < nrows; row += NGW) {
        const int rc = row < TL ? 0 : (row < RL ? 1 : 2);
        const int ybase = row < RL ? (row >> 13) * CAPL : 2 * CAPL + ((row - RL) >> 8) * CAPC;
        const int sl = sl_n; const float af = af_n; f32x4 xc[4];
#pragma unroll
        for (int j = 0; j < 4; ++j) xc[j] = xn[j];
        { const int nr = row + NGW; if (nr < nrows) { sl_n = SLOT[(size_t)nr * 16 + (lane & 15)]; af_n = AFF[(size_t)nr * 16 + (lane & 15)];
#pragma unroll
            for (int j = 0; j < 4; ++j) xn[j] = *(const f32x4*)(XA + (size_t)nr * 1024 + 4 * lane + 256 * j); } }
        f32x4 acc[4];
#pragma unroll
        for (int j = 0; j < 4; ++j) acc[j] = (f32x4){0.f, 0.f, 0.f, 0.f};
        unsigned long long sel = __ballot(lane < 16 && sl >= 0);
#define CB_LD(W, P) do { _Pragma("unroll") for (int j = 0; j < 4; ++j) W[j] = *(const u32x2*)((P) + 256 * j); } while (0)
#define CB_ACC(W, G) do { _Pragma("unroll") for (int j = 0; j < 4; ++j) { acc[j][0] += (G) * __uint_as_float(W[j].x << 16); acc[j][1] += (G) * __uint_as_float(W[j].x & 0xffff0000u); \
            acc[j][2] += (G) * __uint_as_float(W[j].y << 16); acc[j][3] += (G) * __uint_as_float(W[j].y & 0xffff0000u); } } while (0)
        const bool two = !FINAL && row >= RL;
        while (sel) {
            const int e0 = __ffsll((long long)sel) - 1; sel &= sel - 1;
            const int s0 = __builtin_amdgcn_readlane(sl, e0); const float g0 = __builtin_bit_cast(float, __builtin_amdgcn_readlane(__builtin_bit_cast(int, af), e0));
            const bool has1 = sel != 0ull; const int e1 = has1 ? __ffsll((long long)sel) - 1 : e0; if (has1) sel &= sel - 1;
            const int s1 = __builtin_amdgcn_readlane(sl, e1); const float g1 = __builtin_bit_cast(float, __builtin_amdgcn_readlane(__builtin_bit_cast(int, af), e1));
            const size_t o0 = ((size_t)e0 * MROWS + ybase + s0) * 1024 + 4 * lane, o1 = ((size_t)e1 * MROWS + ybase + s1) * 1024 + 4 * lane;
            u32x2 wa[4], wb[4], wc[4], wd[4];
            CB_LD(wa, Y + o0); if (has1) CB_LD(wb, Y + o1);
            if (two) { CB_LD(wc, Y2 + o0); if (has1) CB_LD(wd, Y2 + o1); }
            CB_ACC(wa, g0); if (two) CB_ACC(wc, g0);
            if (has1) { CB_ACC(wb, g1); if (two) CB_ACC(wd, g1); }
        }
#undef CB_LD
#undef CB_ACC
        const float* gt = mod_cur + rc * 6144 + 5 * 1024;
        f32x4 v[4]; float ss = 0.f;
#pragma unroll
        for (int j = 0; j < 4; ++j) { const int c = 4 * lane + 256 * j; v[j] = xc[j] + *(const f32x4*)(gt + c) * acc[j];
            ss += (v[j][0] * v[j][0] + v[j][1] * v[j][1]) + (v[j][2] * v[j][2] + v[j][3] * v[j][3]); }
        const float rstd = rsqrtf(wave_sum(ss) * (1.f / 1024.f) + EPS);
        if (FINAL) {
#pragma unroll
            for (int j = 0; j < 4; ++j) { const int c = 4 * lane + 256 * j; *(f32x4*)(out + (size_t)row * 1024 + c) = v[j] * rstd * *(const f32x4*)(gnext + c); }
        } else {
            const float* scp = mod_next + rc * 6144 + 1 * 1024; const float* shp = mod_next + rc * 6144 + 0 * 1024;
#pragma unroll
            for (int j = 0; j < 4; ++j) { const int c = 4 * lane + 256 * j; *(f32x4*)(XB + (size_t)row * 1024 + c) = v[j];
                const f32x4 h = v[j] * rstd * *(const f32x4*)(gnext + c) * (*(const f32x4*)(scp + c) + 1.f) + *(const f32x4*)(shp + c);
                u32x2 w; w.x = cvtpk(h[0], h[1]); w.y = cvtpk(h[2], h[3]); *(u32x2*)(H + (size_t)row * 1024 + c) = w; }
        }
    }
}
__device__ __forceinline__ void topk_item(int set, int b, int e, const float* AFF, int* ROWIDX, int* SLOT, unsigned char* lds) {
    const int tid = threadIdx.x, lane = tid & 63, wave = tid >> 6;
    const int n = set ? TCX : TL, cap = set ? CAPC : CAPL, row0 = set ? RL + b * TCX : b * TL;
    unsigned* keys = (unsigned*)lds;
    unsigned* hist = (unsigned*)(lds + 32768);
    unsigned* misc = (unsigned*)(lds + 32768 + 1024);
    for (int t = tid; t < n; t += 512) keys[t] = __float_as_uint(AFF[(size_t)(row0 + t) * 16 + e]);
    __syncthreads();
    unsigned prefix = 0u, mask = 0u; int remaining = cap;
    for (int pass = 0; pass < 4; ++pass) {
        const int shift = 24 - 8 * pass;
        if (tid < 256) hist[tid] = 0u;
        __syncthreads();
        if (pass == 0) {
            for (int t = tid; t < n; t += 512) { const unsigned bin = keys[t] >> 24; unsigned long long todo = __ballot(1);
                while (todo) { const int leader = __ffsll((long long)todo) - 1; const unsigned lb = __shfl(bin, leader); const unsigned long long same = __ballot(bin == lb) & todo;
                    if (lane == leader) atomicAdd(&hist[lb], (unsigned)__popcll(same)); todo &= ~same; } }
        } else {
            for (int t = tid; t < n; t += 512) { const unsigned k = keys[t]; if ((k & mask) == prefix) atomicAdd(&hist[(k >> shift) & 255u], 1u); }
        }
        __syncthreads();
        if (wave == 0) {
            unsigned c[4]; unsigned s = 0u;
#pragma unroll
            for (int j = 0; j < 4; ++j) { c[j] = hist[255 - 4 * lane - j]; s += c[j]; }
            unsigned incl = s;
#pragma unroll
            for (int o = 1; o < 64; o <<= 1) { const unsigned v = __shfl_up(incl, o); if (lane >= o) incl += v; }
            const unsigned excl = incl - s;
            if (excl < (unsigned)remaining && (unsigned)remaining <= incl) { unsigned run = excl; int bin = 0; unsigned nr = 0u; bool found = false;
#pragma unroll
                for (int j = 0; j < 4; ++j) { if (!found) { if (run + c[j] >= (unsigned)remaining) { bin = 255 - 4 * lane - j; nr = (unsigned)remaining - run; found = true; } else run += c[j]; } }
                misc[0] = (unsigned)bin; misc[1] = nr; }
        }
        __syncthreads();
        prefix |= misc[0] << shift; mask |= 255u << shift; remaining = (int)misc[1];
        __syncthreads();
    }
    const unsigned T = prefix;
    const int per = n >= 512 ? n / 512 : 1, t0 = tid * per, cnt = (t0 < n) ? per : 0;
    unsigned cg = 0u, ce = 0u;
    for (int j = 0; j < cnt; ++j) { const unsigned k = keys[t0 + j]; cg += (k > T) ? 1u : 0u; ce += (k == T) ? 1u : 0u; }
    const unsigned pk = cg | (ce << 16);
    unsigned incl = pk;
#pragma unroll
    for (int o = 1; o < 64; o <<= 1) { const unsigned v = __shfl_up(incl, o); if (lane >= o) incl += v; }
    if (lane == 63) misc[8 + wave] = incl;
    __syncthreads();
    unsigned wbase = 0u;
    for (int w = 0; w < wave; ++w) wbase += misc[8 + w];
    unsigned run = wbase + incl - pk;
    unsigned g_before = run & 0xffffu, e_before = run >> 16;
    const int xs_base = set ? 2 * CAPL + b * CAPC : b * CAPL;
    int* idxp = ROWIDX + e * MROWS + xs_base;
    for (int j = 0; j < cnt; ++j) { const int t = t0 + j; const unsigned k = keys[t];
        const bool take = (k > T) || (k == T && e_before < (unsigned)remaining);
        const int slot = (int)(g_before + (e_before < (unsigned)remaining ? e_before : (unsigned)remaining));
        SLOT[(size_t)(row0 + t) * 16 + e] = take ? slot : -1;
        if (take) idxp[slot] = row0 + t;
        g_before += (k > T) ? 1u : 0u; e_before += (k == T) ? 1u : 0u; }
    __syncthreads();
}
__device__ __forceinline__ int chunk_row0(int b, int tc) { return tc < 4 ? RL + b * TCX + tc * 64 : b * TL + (tc - 4) * 64; }
__device__ __forceinline__ int chunk_seq(int dir, int tc) { return dir ? (tc < 4 ? 3 - tc : 135 - tc) : tc; }

struct Gla1In { f32x2 lf[8]; };
__device__ __forceinline__ void gla1_load(Gla1In& in, int b, int h, int tc, const bf16* LF) {
    const int tid = threadIdx.x, kp = tid & 63, seg = tid >> 6, row0 = chunk_row0(b, tc);
#pragma unroll
    for (int j = 0; j < 8; ++j) { const unsigned w = *(const unsigned*)(LF + (size_t)(row0 + 8 * seg + j) * 1024 + h * 128 + 2 * kp); in.lf[j] = (f32x2){__uint_as_float(w << 16), __uint_as_float(w & 0xffff0000u)}; }
}
__device__ __forceinline__ void gla1_loadv(bf16x8 (&v)[2], int b, int h, int tc, const bf16* V) {
    const int tid = threadIdx.x, sr = tid >> 4, sc = (tid & 15) * 8, row0 = chunk_row0(b, tc);
    v[0] = *(const bf16x8*)(V + (size_t)(row0 + sr) * 1024 + h * 128 + sc); v[1] = *(const bf16x8*)(V + (size_t)(row0 + 32 + sr) * 1024 + h * 128 + sc);
}
template <int DIR> __device__ __forceinline__ void gla1_dir(const Gla1In& in, int b, int h, int tc, bf16* P, float* DD, unsigned char* lds) {
    const int tid = threadIdx.x, lane = tid & 63, wave = tid >> 6, r32 = lane & 31, hi = lane >> 5, kp = tid & 63, seg = tid >> 6;
    unsigned char* KHT = lds; unsigned char* VT = lds + 16384; float* TOT = (float*)(lds + 32768);
    const int n = chunk_seq(DIR, tc), chain = DIR * 16 + b * 8 + h;
    f32x2 c[8]; f32x2 run = {0.f, 0.f};
#pragma unroll
    for (int j = 0; j < 8; ++j) { run += in.lf[j]; c[j] = run; }
    *(f32x2*)(TOT + seg * 128 + 2 * kp) = run;
    __syncthreads();
    f32x2 off = {0.f, 0.f}, tot = {0.f, 0.f};
#pragma unroll
    for (int s = 0; s < 8; ++s) { const f32x2 t = *(const f32x2*)(TOT + s * 128 + 2 * kp); if (s < seg) off += t; tot += t; }
    unsigned w0[4], w1[4];
#pragma unroll
    for (int j = 0; j < 8; j += 2) { float a[2], bb[2];
#pragma unroll
        for (int q = 0; q < 2; ++q) { const f32x2 cc = off + c[j + q]; const f32x2 l = in.lf[j + q];
            a[q] = (1.f - __builtin_amdgcn_exp2f(l[0])) * __builtin_amdgcn_exp2f(DIR ? (cc[0] - l[0]) : (tot[0] - cc[0])); bb[q] = (1.f - __builtin_amdgcn_exp2f(l[1])) * __builtin_amdgcn_exp2f(DIR ? (cc[1] - l[1]) : (tot[1] - cc[1])); }
        w0[j >> 1] = cvtpk(a[0], a[1]); w1[j >> 1] = cvtpk(bb[0], bb[1]); }
    *(u32x4*)(KHT + KSWZ64(2 * kp, seg * 16)) = (u32x4){w0[0], w0[1], w0[2], w0[3]};
    *(u32x4*)(KHT + KSWZ64(2 * kp + 1, seg * 16)) = (u32x4){w1[0], w1[1], w1[2], w1[3]};
    if (seg == 0) *(f32x2*)(DD + (size_t)(chain * NCH + n) * 128 + 2 * kp) = (f32x2){__builtin_amdgcn_exp2f(tot[0]), __builtin_amdgcn_exp2f(tot[1])};
    __syncthreads();
    const int kb = wave >> 1, vh = wave & 1, vb = (int)(uintptr_t)VT + v_rd_base(lane);
    bf16x8 pa[4];
#pragma unroll
    for (int s = 0; s < 4; ++s) pa[s] = *(const bf16x8*)(KHT + KSWZ64(32 * kb + r32, (16 * s + 8 * hi) * 2));
    bf16* Pn = P + (size_t)(chain * NCH + n) * 16384;
#pragma unroll
    for (int jj = 0; jj < 2; ++jj) { const int d0 = 2 * vh + jj; f32x16 od = {};
        pvb(od, vb + d0 * 512, pa[0], pa[1], pa[2], pa[3]);
#pragma unroll
        for (int r = 0; r < 16; ++r) Pn[(32 * kb + crow(r, hi)) * 128 + 32 * d0 + r32] = (bf16)cvtpk_mf(od[r], 0.f); }
    __syncthreads();
}
__device__ __forceinline__ void gla1_item(Gla1In& fw, bf16x8 (&vin)[2], int b, int h, int tc, bool has_next, int nb, int nh, int ntc, const bf16* LFF, const bf16* LFB, const bf16* V, bf16* P, float* DD, unsigned char* lds) {
    const int tid = threadIdx.x;
    unsigned char* VT = lds + 16384;
    Gla1In bw; gla1_load(bw, b, h, tc, LFB);
    { const int sr = tid >> 4, sc = (tid & 15) * 8;
      *(bf16x8*)(VT + v_st(sr, sc)) = vin[0]; *(bf16x8*)(VT + v_st(32 + sr, sc)) = vin[1]; }
    gla1_dir<0>(fw, b, h, tc, P, DD, lds);
    if (has_next) { gla1_load(fw, nb, nh, ntc, LFF); gla1_loadv(vin, nb, nh, ntc, V); }
    gla1_dir<1>(bw, b, h, tc, P, DD, lds);
}
__device__ __forceinline__ void gla2_phase(const bf16* P, const float* DD, bf16* SS, int vcu, int G) {
    for (int gid = vcu * 512 + (int)threadIdx.x; gid < 131072; gid += G * 512) {
        const int chain = gid >> 12, rem = gid & 4095, k = rem >> 5, v4 = rem & 31;
        const size_t base = (size_t)chain * NCH * 16384 + k * 128 + v4 * 4; const float* dp = DD + (size_t)chain * NCH * 128 + k;
        f32x4 S = {0.f, 0.f, 0.f, 0.f};
#pragma unroll 6
        for (int n = 0; n < NCH; ++n) { const u32x2 pw = *(const u32x2*)(P + base + (size_t)n * 16384); const float d = dp[n * 128];
            const f32x4 p = {__uint_as_float(pw.x << 16), __uint_as_float(pw.x & 0xffff0000u), __uint_as_float(pw.y << 16), __uint_as_float(pw.y & 0xffff0000u)};
            u32x2 w; w.x = cvtpk(S[0], S[1]); w.y = cvtpk(S[2], S[3]); *(u32x2*)(SS + base + (size_t)n * 16384) = w;
            S = S * d + p; }
    }
}
struct GlaIn { f32x2 lf[8]; unsigned q[8]; bf16x8 v[2]; bf16x8 s[4]; };
template <int DIR> __device__ __forceinline__ void gla3_load(GlaIn& in, int b, int h, int tc, const bf16* Q, const bf16* LF, const bf16* V, const bf16* SS) {
    const int tid = threadIdx.x, kp = tid & 63, seg = tid >> 6, row0 = chunk_row0(b, tc), n = chunk_seq(DIR, tc), chain = DIR * 16 + b * 8 + h;
#pragma unroll
    for (int j = 0; j < 8; ++j) { const int p = 8 * seg + j, t = DIR ? 63 - p : p; const size_t o = (size_t)(row0 + t) * 1024 + h * 128 + 2 * kp;
        { const unsigned w = *(const unsigned*)(LF + o); in.lf[j] = (f32x2){__uint_as_float(w << 16), __uint_as_float(w & 0xffff0000u)}; } in.q[j] = *(const unsigned*)(Q + o); }
    const int sr = tid >> 4, sc = (tid & 15) * 8;
#pragma unroll
    for (int q = 0; q < 2; ++q) { const int p = sr + 32 * q, t = DIR ? 63 - p : p; in.v[q] = *(const bf16x8*)(V + (size_t)(row0 + t) * 1024 + h * 128 + sc); }
    const bf16* Sg = SS + (size_t)(chain * NCH + n) * 16384;
#pragma unroll
    for (int q = 0; q < 4; ++q) in.s[q] = *(const bf16x8*)(Sg + (size_t)(sr + 32 * q) * 128 + sc);
}
__device__ __forceinline__ void gla3_scale(const GlaIn& in, unsigned char* lds) {
    const int tid = threadIdx.x;
    const int kp = tid & 63, seg = tid >> 6;
    unsigned char* QIN = lds; unsigned char* QD = lds + 16384; unsigned char* KD = lds + 32768; unsigned char* QO = lds + 49152; unsigned char* KO = lds + 57344;
    unsigned char* VT = lds + 65536; unsigned char* ST = lds + 81920; float* TOT = (float*)(lds + 114688);
    f32x2 c[8]; f32x2 run = {0.f, 0.f};
#pragma unroll
    for (int j = 0; j < 8; ++j) { run += in.lf[j]; c[j] = run; }
    *(f32x2*)(TOT + seg * 128 + 2 * kp) = run;
    { const int sr = tid >> 4, sc = (tid & 15) * 8;
#pragma unroll
      for (int q = 0; q < 2; ++q) *(bf16x8*)(VT + v_st(sr + 32 * q, sc)) = in.v[q];
#pragma unroll
      for (int q = 0; q < 4; ++q) { const int kr = sr + 32 * q; *(bf16x8*)(ST + (kr >> 6) * 16384 + v_st(kr & 63, sc)) = in.s[q]; } }
    __syncthreads();
    { f32x2 cum[8]; f32x2 acc = {0.f, 0.f};
#pragma unroll
      for (int s = 0; s < 8; ++s) { cum[s] = acc; acc += *(const f32x2*)(TOT + s * 128 + 2 * kp); }
      f32x2 off = cum[0];
#pragma unroll
      for (int s = 1; s < 8; ++s) off = (seg == s) ? cum[s] : off;
      const f32x2 e0 = cum[2], e1 = cum[4], e2 = cum[6];
      const f32x2 mref = seg < 4 ? e0 : e2, rref = e1;
      const float em[2] = {__builtin_amdgcn_exp2f(mref[0]), __builtin_amdgcn_exp2f(mref[1])};
      const float er[2] = {__builtin_amdgcn_exp2f(seg < 4 ? rref[0] - mref[0] : mref[0] - rref[0]), __builtin_amdgcn_exp2f(seg < 4 ? rref[1] - mref[1] : mref[1] - rref[1])};
#pragma unroll
      for (int j = 0; j < 8; ++j) { const int p = 8 * seg + j; const f32x2 cc = off + c[j];
          const float k0 = 1.f - __builtin_amdgcn_exp2f(in.lf[j][0]), k1 = 1.f - __builtin_amdgcn_exp2f(in.lf[j][1]);
          const float q0 = __uint_as_float(in.q[j] << 16), q1 = __uint_as_float(in.q[j] & 0xffff0000u);
          const int a = KSWZ(p, kp * 4);
          const float qd0 = q0 * __builtin_amdgcn_exp2f(cc[0] - mref[0]), qd1 = q1 * __builtin_amdgcn_exp2f(cc[1] - mref[1]);
          const float kd0 = k0 * __builtin_amdgcn_exp2f(mref[0] - cc[0]), kd1 = k1 * __builtin_amdgcn_exp2f(mref[1] - cc[1]);
          *(unsigned*)(QIN + a) = cvtpk(qd0 * em[0], qd1 * em[1]);
          *(unsigned*)(QD + a) = cvtpk(qd0, qd1);
          *(unsigned*)(KD + a) = cvtpk(kd0, kd1);
          if (seg < 4) *(unsigned*)(KO + a) = cvtpk(kd0 * er[0], kd1 * er[1]);
          else *(unsigned*)(QO + KSWZ(p - 32, kp * 4)) = cvtpk(qd0 * er[0], qd1 * er[1]); } }
    __syncthreads();
}
__device__ __forceinline__ f32x16 gla3_mma(unsigned char* lds) {
    const int tid = threadIdx.x, lane = tid & 63, wave = tid >> 6, r32 = lane & 31, hi = lane >> 5;
    unsigned char* QIN = lds; unsigned char* QD = lds + 16384; unsigned char* KD = lds + 32768; unsigned char* QO = lds + 49152; unsigned char* KO = lds + 57344;
    unsigned char* VT = lds + 65536; unsigned char* ST = lds + 81920;
    const int i = wave >> 2, d0 = wave & 3;
    const int vbV = (int)(uintptr_t)VT + v_rd_base(lane) + d0 * 512, vbS = (int)(uintptr_t)ST + v_rd_base(lane) + d0 * 512;
    f32x16 od = {};
    { bf16x8 qa[8];
#pragma unroll
      for (int s = 0; s < 8; ++s) qa[s] = *(const bf16x8*)(QIN + KSWZ(32 * i + r32, (16 * s + 8 * hi) * 2));
      pvb(od, vbS, qa[0], qa[1], qa[2], qa[3]); pvb(od, vbS + 16384, qa[4], qa[5], qa[6], qa[7]); }
    f32x16 pd = {};
#pragma unroll
    for (int s = 0; s < 8; ++s) { const int cb = (16 * s + 8 * hi) * 2;
        pd = __builtin_amdgcn_mfma_f32_32x32x16_bf16(*(const bf16x8*)(KD + KSWZ(32 * i + r32, cb)), *(const bf16x8*)(QD + KSWZ(32 * i + r32, cb)), pd, 0, 0, 0); }
#pragma unroll
    for (int r = 0; r < 16; ++r) pd[r] = (crow(r, hi) <= r32) ? pd[r] : 0.f;
    f32x16 p0, p1;
    if (i == 1) { f32x16 po = {};
#pragma unroll
        for (int s = 0; s < 8; ++s) { const int cb = (16 * s + 8 * hi) * 2;
            po = __builtin_amdgcn_mfma_f32_32x32x16_bf16(*(const bf16x8*)(KO + KSWZ(r32, cb)), *(const bf16x8*)(QO + KSWZ(r32, cb)), po, 0, 0, 0); }
        p0 = po; p1 = pd; }
    else { p0 = pd; p1 = (f32x16){}; }
    bf16x8 pa0, pa1, pa2, pa3;
    PK4(p0, 0, pa0); PK4(p0, 8, pa1); PK4(p1, 0, pa2); PK4(p1, 8, pa3);
    pvb(od, vbV, pa0, pa1, pa2, pa3);
    __syncthreads();
    return od;
}
__device__ __forceinline__ void gla3_item(GlaIn& cur, int b, int h, int tc, bool has_next, int nb, int nh, int ntc, const bf16* Q, const bf16* LFF, const bf16* LFB, const bf16* V, const bf16* SG, const bf16* SS, const float* gn, bf16* OM, unsigned char* lds) {
    const int tid = threadIdx.x, lane = tid & 63, wave = tid >> 6, r32 = lane & 31, hi = lane >> 5, row0 = chunk_row0(b, tc);
    GlaIn bw;
    gla3_scale(cur, lds); gla3_load<1>(bw, b, h, tc, Q, LFB, V, SS);
    const f32x16 of = gla3_mma(lds);
    gla3_scale(bw, lds); if (has_next) gla3_load<0>(cur, nb, nh, ntc, Q, LFF, V, SS);
    const f32x16 ob = gla3_mma(lds);
    float* OUT = (float*)lds;
    const int i = wave >> 2, d0 = wave & 3;
    unsigned sgw[8];
#pragma unroll
    for (int rr = 0; rr < 8; ++rr) sgw[rr] = *(const unsigned*)(SG + (size_t)(row0 + 8 * wave + rr) * 1024 + h * 128 + 2 * lane);
#pragma unroll
    for (int r = 0; r < 16; ++r) OUT[(32 * i + crow(r, hi)) * 132 + 32 * d0 + r32] = of[r];
    __syncthreads();
#pragma unroll
    for (int r = 0; r < 16; ++r) OUT[(63 - (32 * i + crow(r, hi))) * 132 + 32 * d0 + r32] += ob[r];
    __syncthreads();
    const f32x2 g = *(const f32x2*)(gn + 2 * lane);
#pragma unroll
    for (int rr = 0; rr < 8; ++rr) { const int t = 8 * wave + rr; const f32x2 o = *(const f32x2*)(OUT + t * 132 + 2 * lane);
        const float rstd = rsqrtf(wave_sum(o[0] * o[0] + o[1] * o[1]) * (1.f / 128.f) + EPS);
        const size_t off = (size_t)(row0 + t) * 1024 + h * 128 + 2 * lane;
        *(unsigned*)(OM + off) = cvtpk(o[0] * rstd * g[0] * __uint_as_float(sgw[rr] << 16), o[1] * rstd * g[1] * __uint_as_float(sgw[rr] & 0xffff0000u)); }
    __syncthreads();
}
constexpr int AT_STG = 32768, AT_KOFF = 16384, AT_Q = 65536, AT_LI = 131072, ATT_NT = 132;
__device__ __forceinline__ void att_exp16(f32x16& p, bool need, float sh) {
#pragma unroll
    for (int r = 0; r < 16; ++r) p[r] = __builtin_amdgcn_exp2f(p[r]);
}
__device__ __forceinline__ void att_soft(f32x16& p0, f32x16& p1, float& l_reg, bf16x8& pa0, bf16x8& pa1, bf16x8& pa2, bf16x8& pa3, bool need, float sh) {
    att_exp16(p0, need, sh); att_exp16(p1, need, sh);
    float s0 = 0.f, s1 = 0.f, s2 = 0.f, s3 = 0.f;
#pragma unroll
    for (int r = 0; r < 16; r += 4) { s0 += p0[r]; s1 += p0[r + 1]; s2 += p0[r + 2]; s3 += p0[r + 3]; }
#pragma unroll
    for (int r = 0; r < 16; r += 4) { s0 += p1[r]; s1 += p1[r + 1]; s2 += p1[r + 2]; s3 += p1[r + 3]; }
    l_reg += (s0 + s1) + (s2 + s3);
#define PK4N(P, BASE, OUT) do { u32x4 w_ = {cvtpk(P[BASE + 0], P[BASE + 1]), cvtpk(P[BASE + 2], P[BASE + 3]), cvtpk(P[BASE + 4], P[BASE + 5]), cvtpk(P[BASE + 6], P[BASE + 7])}; OUT = *reinterpret_cast<bf16x8*>(&w_); } while (0)
    PK4N(p0, 0, pa0); PK4N(p0, 8, pa1); PK4N(p1, 0, pa2); PK4N(p1, 8, pa3);
#undef PK4N
}
template <int COMP> __device__ __forceinline__ void att_qkt(f32x16& p0, f32x16& p1, const unsigned char* Ks, const unsigned char* ql, int koff0, const bf16x8* qreg, float ci) {
    f32x16 c0; for (int r = 0; r < 16; ++r) c0[r] = ci;
    const bf16x8* qr = (const bf16x8*)ql;
    p0 = __builtin_amdgcn_mfma_f32_32x32x16_bf16(*reinterpret_cast<const bf16x8*>(Ks + koff0 + (4 * COMP) * 2048), qreg[4 * COMP], c0, 0, 0, 0);
    p1 = __builtin_amdgcn_mfma_f32_32x32x16_bf16(*reinterpret_cast<const bf16x8*>(Ks + koff0 + 1024 + (4 * COMP) * 2048), qreg[4 * COMP], c0, 0, 0, 0);
#pragma unroll
    for (int d = 1; d < 4; ++d) { const int d0 = 4 * COMP + d;
        p0 = __builtin_amdgcn_mfma_f32_32x32x16_bf16(*reinterpret_cast<const bf16x8*>(Ks + koff0 + d0 * 2048), qreg[d0], p0, 0, 0, 0);
        p1 = __builtin_amdgcn_mfma_f32_32x32x16_bf16(*reinterpret_cast<const bf16x8*>(Ks + koff0 + 1024 + d0 * 2048), qreg[d0], p1, 0, 0, 0); }
}
template <int BO> __device__ __forceinline__ void pvb_t(f32x16& od, int vb, bf16x8 pa0, bf16x8 pa1, bf16x8 pa2, bf16x8 pa3) {
    const s16x4 l0 = tr_read<BO + v_rd_off(0, 0, 0)>(vb), h0 = tr_read<BO + v_rd_off(0, 0, 1)>(vb), l1 = tr_read<BO + v_rd_off(0, 1, 0)>(vb), h1 = tr_read<BO + v_rd_off(0, 1, 1)>(vb);
    const s16x4 l2 = tr_read<BO + v_rd_off(0, 2, 0)>(vb), h2 = tr_read<BO + v_rd_off(0, 2, 1)>(vb), l3 = tr_read<BO + v_rd_off(0, 3, 0)>(vb), h3 = tr_read<BO + v_rd_off(0, 3, 1)>(vb);
    asm volatile("s_waitcnt lgkmcnt(0)" ::: "memory"); SBAR();
#define PKV(L, H) (bf16x8){L[0], L[1], L[2], L[3], H[0], H[1], H[2], H[3]}
    od = __builtin_amdgcn_mfma_f32_32x32x16_bf16(pa0, PKV(l0, h0), od, 0, 0, 0);
    od = __builtin_amdgcn_mfma_f32_32x32x16_bf16(pa1, PKV(l1, h1), od, 0, 0, 0);
    od = __builtin_amdgcn_mfma_f32_32x32x16_bf16(pa2, PKV(l2, h2), od, 0, 0, 0);
    od = __builtin_amdgcn_mfma_f32_32x32x16_bf16(pa3, PKV(l3, h3), od, 0, 0, 0);
#undef PKV
}
#define TR8(BO, L0, H0, L1, H1, L2, H2, L3, H3) do { L0 = tr_read<BO + v_rd_off(0, 0, 0)>(vb); H0 = tr_read<BO + v_rd_off(0, 0, 1)>(vb); L1 = tr_read<BO + v_rd_off(0, 1, 0)>(vb); H1 = tr_read<BO + v_rd_off(0, 1, 1)>(vb); \
    L2 = tr_read<BO + v_rd_off(0, 2, 0)>(vb); H2 = tr_read<BO + v_rd_off(0, 2, 1)>(vb); L3 = tr_read<BO + v_rd_off(0, 3, 0)>(vb); H3 = tr_read<BO + v_rd_off(0, 3, 1)>(vb); } while (0)
#define PKV(L, H) (bf16x8){L[0], L[1], L[2], L[3], H[0], H[1], H[2], H[3]}
#define MM4(OD, L0, H0, L1, H1, L2, H2, L3, H3) do { OD = __builtin_amdgcn_mfma_f32_32x32x16_bf16(pa0, PKV(L0, H0), OD, 0, 0, 0); OD = __builtin_amdgcn_mfma_f32_32x32x16_bf16(pa1, PKV(L1, H1), OD, 0, 0, 0); \
    OD = __builtin_amdgcn_mfma_f32_32x32x16_bf16(pa2, PKV(L2, H2), OD, 0, 0, 0); OD = __builtin_amdgcn_mfma_f32_32x32x16_bf16(pa3, PKV(L3, H3), OD, 0, 0, 0); } while (0)
template <int VO> __device__ __forceinline__ void att_pv(f32x16* o, int vb, bf16x8 pa0, bf16x8 pa1, bf16x8 pa2, bf16x8 pa3) {
    s16x4 al0, ah0, al1, ah1, al2, ah2, al3, ah3, bl0, bh0, bl1, bh1, bl2, bh2, bl3, bh3;
    TR8(VO, al0, ah0, al1, ah1, al2, ah2, al3, ah3);
    TR8(VO + 512, bl0, bh0, bl1, bh1, bl2, bh2, bl3, bh3);
    asm volatile("s_waitcnt lgkmcnt(8)" ::: "memory"); SBAR(); MM4(o[0], al0, ah0, al1, ah1, al2, ah2, al3, ah3); SBAR();
    TR8(VO + 1024, al0, ah0, al1, ah1, al2, ah2, al3, ah3);
    asm volatile("s_waitcnt lgkmcnt(8)" ::: "memory"); SBAR(); MM4(o[1], bl0, bh0, bl1, bh1, bl2, bh2, bl3, bh3); SBAR();
    TR8(VO + 1536, bl0, bh0, bl1, bh1, bl2, bh2, bl3, bh3);
    asm volatile("s_waitcnt lgkmcnt(8)" ::: "memory"); SBAR(); MM4(o[2], al0, ah0, al1, ah1, al2, ah2, al3, ah3); SBAR();
    asm volatile("s_waitcnt lgkmcnt(0)" ::: "memory"); SBAR(); MM4(o[3], bl0, bh0, bl1, bh1, bl2, bh2, bl3, bh3);
}
#undef TR8
#undef PKV
#undef MM4
__device__ __forceinline__ void attn_item(const bf16* __restrict__ QA, const bf16* __restrict__ KA, const bf16* __restrict__ VA, bf16* __restrict__ OM, const unsigned* __restrict__ KMX,
                                          const float* __restrict__ lamp, const float* __restrict__ subln, int b, int h, int qb, unsigned char* lds) {
    const int tid = threadIdx.x, wid = tid >> 6, lane = tid & 63, r32 = lane & 31, hi = lane >> 5;
    float l0 = 0.f, l1 = 0.f; f32x16 o0[4] = {}, o1[4] = {};
    const int qrow0 = b * TL + qb * 256 + wid * 32;
    unsigned char* qlds = lds + AT_Q + wid * 8192 + lane * 16;
    float sh; bool need; bf16x8 qreg0[8];
    { const bf16* Qw = QA + (size_t)(qrow0 + r32) * 1024 + h * 128 + hi * 8; float q2a = 0.f, q2b = 0.f;
#pragma unroll
      for (int d0 = 0; d0 < 8; ++d0) { const bf16x8 qv = *reinterpret_cast<const bf16x8*>(Qw + d0 * 16); *(bf16x8*)(qlds + d0 * 1024) = qv; qreg0[d0] = qv; float s = 0.f;
#pragma unroll
          for (int j = 0; j < 8; ++j) { const float x = bf2f((unsigned short)qv[j]); s += x * x; }
          if (d0 < 4) q2a += s; else q2b += s; }
      q2a += __shfl_xor(q2a, 32); q2b += __shfl_xor(q2b, 32);
      const unsigned* km = KMX + b * 32 + h * 4;
      const float ma = sqrtf(q2a * (__uint_as_float(km[0]) + __uint_as_float(km[1]))), mb = sqrtf(q2b * (__uint_as_float(km[2]) + __uint_as_float(km[3])));
      const float mrow = fmaxf(ma, mb) * 1.01f + 0.01f;
      sh = mrow > 60.f ? mrow - 60.f : 0.f; need = __any(sh > 0.f); }
    const float cinit = -sh;
    const int koff0 = AT_KOFF + r32 * 32 + ((hi ^ ((r32 >> 3) & 1)) << 4);
    const int vb0 = (int)(uintptr_t)lds + v_rd_base(lane);
    const int wu = __builtin_amdgcn_readfirstlane(wid);
    unsigned goff0;
    { const int pc = wu * 4; int key, col;
      if (pc < 16) { const int sub = 2 * pc + (lane >> 5), kk = (sub >> 2) * 8 + ((lane & 31) >> 2); key = kk; col = (sub & 3) * 32 + (lane & 3) * 8; }
      else { const int q = pc - 16; key = (q & 1) * 32 + (lane >> 1); col = (q >> 1) * 16 + (((lane & 1) ^ ((key >> 3) & 1)) << 3); }
      goff0 = (unsigned)(key * 1024 + h * 128 + col) * 2u; }
    const int gd1 = (wu < 4) ? 64 : 32 * 1024, gd2 = (wu < 4) ? 8 * 1024 : 16;
    const bf16* srcb = (wu < 4) ? VA : KA;
    const int ldst = (wu < 4 ? 0 : AT_KOFF - 16384) + wu * 4096;
#define TROW(j) ((j) < 4 ? (RL + b * TCX + (j) * 64) : (b * TL + ((j) - 4) * 64))
#define SDMA(st, j) do { const bf16* tb_ = srcb + (size_t)TROW(j) * 1024; unsigned g_ = goff0; asm volatile("" : "+v"(g_));   \
        _Pragma("unroll") for (int i_ = 0; i_ < 4; ++i_) \
        __builtin_amdgcn_global_load_lds((const unsigned*)((const char*)(tb_ + (i_ & 1) * gd1 + (i_ >> 1) * gd2) + g_), (LAS unsigned*)(lds + (st) * AT_STG + ldst + i_ * 1024), 16, 0, 0); } while (0)
    f32x16 pA0, pA1; bf16x8 pa0, pa1, pa2, pa3; constexpr int NT = ATT_NT;
#define STEP(ST, jj) do { __syncthreads(); \
        SDMA(1 - (ST), ((jj) + 1 < NT) ? (jj) + 1 : NT - 1); \
        SBAR(); att_qkt<0>(pA0, pA1, lds + (ST) * AT_STG, qlds, koff0, qreg0, cinit); \
        att_soft(pA0, pA1, l0, pa0, pa1, pa2, pa3, need, sh); \
        att_pv<(ST) * AT_STG>(o0, vb0, pa0, pa1, pa2, pa3); \
        att_qkt<1>(pA0, pA1, lds + (ST) * AT_STG, qlds, koff0, qreg0, cinit); \
        att_soft(pA0, pA1, l1, pa0, pa1, pa2, pa3, need, sh); \
        att_pv<(ST) * AT_STG>(o1, vb0, pa0, pa1, pa2, pa3); } while (0)
    SDMA(0, 0);
    for (int j = 0; j < NT; j += 2) {
        STEP(0, j);
        STEP(1, j + 1);
    }
    asm volatile("s_waitcnt vmcnt(0)" ::: "memory");
#undef STEP
#undef TROW
#undef SDMA
    l0 += __shfl_xor(l0, 32); l1 += __shfl_xor(l1, 32);
    int t2_ = tid; asm volatile("" : "+v"(t2_));
    const int r32e = t2_ & 31, hie = (t2_ >> 5) & 1; float* li_e = (float*)(lds + AT_LI) + (t2_ >> 6) * 64;
    if (hie == 0) { li_e[r32e] = l0; li_e[32 + r32e] = l1; } asm volatile("s_waitcnt lgkmcnt(0)" ::: "memory");
    const float lam = lamp[0], oml = lamp[1];
    float gsub[4];
#pragma unroll
    for (int d0 = 0; d0 < 4; ++d0) gsub[d0] = subln[d0 * 32 + r32e] * oml;
    bf16* Ow = OM + (size_t)(b * TL + qb * 256 + (t2_ >> 6) * 32) * 1024 + h * 128 + r32e;
#pragma unroll
    for (int r = 0; r < 16; ++r) { const int orow = crow(r, hie); const float ra = __builtin_amdgcn_rcpf(li_e[orow]), rb = lam * __builtin_amdgcn_rcpf(li_e[32 + orow]);
        float v[4]; float ss = 0.f;
#pragma unroll
        for (int d0 = 0; d0 < 4; ++d0) { v[d0] = o0[d0][r] * ra - o1[d0][r] * rb; ss += v[d0] * v[d0]; }
        ss += __shfl_xor(ss, 1); ss += __shfl_xor(ss, 2); ss += __shfl_xor(ss, 4); ss += __shfl_xor(ss, 8); ss += __shfl_xor(ss, 16);
        const float rstd = rsqrtf(ss * (1.f / 128.f) + EPS);
#pragma unroll
        for (int d0 = 0; d0 < 4; ++d0) Ow[(size_t)orow * 1024 + d0 * 32] = (bf16)cvtpk(v[d0] * rstd * gsub[d0], 0.f); }
    __syncthreads();
}
#ifndef MK_MULTI
#define MK_MULTI 0
#endif
constexpr int NPHASES = 20;
__global__ void __launch_bounds__(NWAVES * 64, 2) __attribute__((target("no-packed-fp32-ops"))) mk_fwd(Args args) {
    extern __shared__ __attribute__((aligned(16))) unsigned char lds[];
    LAS unsigned char* ldsL = (LAS unsigned char*)lds;
    const int tid = threadIdx.x, G = gridDim.x, bx = blockIdx.x;
    const int vcu = (G % 8 == 0) ? (bx % 8) * (G / 8) + bx / 8 : bx;
    unsigned char* ws = args.ws;
    for (int u = tid; u < (LDS_BYTES - 131072) / 4; u += NWAVES * 64) ((LAS unsigned*)(ldsL + 131072))[u] = 0u;
    __syncthreads();
    const int lo = args.ph_lo, hi = args.ph_hi;
    XcdBarrier bar; bar.bar = (unsigned*)(ws + WS_CTL) + CW_BAR; bar.x = 0; bar.st = (volatile LAS unsigned*)(ldsL + MISC_OFF) + 8;
    if (hi - lo > 1) bar = xcd_barrier_post((unsigned*)(ws + WS_CTL) + CW_BAR, (volatile LAS unsigned*)(ldsL + MISC_OFF) + 8);
#define IN(k) (lo <= (k) && (k) < hi)
#define SEAM(k) do { if (IN(k) && IN((k) + 1)) xcd_barrier(bar); } while (0)
    float* TAB = (float*)(ws + WS_TAB); float* MOD0 = TAB + TAB_MOD / 4; float* MOD1 = MOD0 + 3 * 6144;
    const float* LB = TAB + TAB_LB / 4; const float* LAM = TAB + TAB_LAM / 4; const float* ROPE = TAB + TAB_ROPE / 4;
    bf16* H = (bf16*)(ws + WS_H); bf16* OM = (bf16*)(ws + WS_OMIX); float* XA = (float*)(ws + WS_XA); float* XB = (float*)(ws + WS_XB);
    float* AFF = (float*)(ws + WS_AFF); int* SLOT = (int*)(ws + WS_SLOT); int* ROWIDX = (int*)(ws + WS_IDX);
    bf16* XS = (bf16*)(ws + WS_XS); bf16* ACT = (bf16*)(ws + WS_ACT); bf16* Y = (bf16*)(ws + WS_Y); bf16* Y2 = (bf16*)(ws + WS_Y2);
    unsigned* KMX = (unsigned*)(ws + WS_CTL) + CW_KMX;
    (void)LAM; (void)ROPE; (void)LB; (void)XB; (void)ROWIDX; (void)XS;

    if (IN(0)) { p0_prologue(args, ldsL, vcu, G); }
    SEAM(0);
    if (IN(1)) { norm_phase<false>(args.in[0], args.in[2], RT, args.in[6], MOD0, 0, 1, H, nullptr, nullptr, ldsL, vcu, G); }
    SEAM(1);
    if (IN(2)) { pg8::Gemm g{H, (const bf16*)(ws + WS_WHIN), RT, 5120, 1024, nullptr}; pg8::TailOrder S; S.init(64, 20, G, bx, 64, 0, 2, 20);
        pg8::EpiHin E{(bf16*)(ws + WS_Q), (bf16*)(ws + WS_LFF), (bf16*)(ws + WS_LFB), (bf16*)(ws + WS_V), (bf16*)(ws + WS_SG), LB};
        pg8::gemm_phase<pg8::EpiHin, pg8::TailOrder, true, true>(ldsL, g, S, E); }
    SEAM(2);
    if (IN(3)) { { Gla1In gin; bf16x8 vin[2] = {}; int it = vcu; if (it < NB * NH * NCH) { gla1_load(gin, (it / NCH) >> 3, (it / NCH) & 7, it % NCH, (const bf16*)(ws + WS_LFF)); gla1_loadv(vin, (it / NCH) >> 3, (it / NCH) & 7, it % NCH, (const bf16*)(ws + WS_V)); }
          for (; it < NB * NH * NCH; it += G) { const int tc = it % NCH, bh = it / NCH, nit = it + G; const bool hn = nit < NB * NH * NCH; const int nbh = hn ? nit / NCH : bh, ntc = hn ? nit % NCH : tc;
            gla1_item(gin, vin, bh >> 3, bh & 7, tc, hn, nbh >> 3, nbh & 7, ntc, (const bf16*)(ws + WS_LFF), (const bf16*)(ws + WS_LFB), (const bf16*)(ws + WS_V), (bf16*)(ws + WS_P), (float*)(ws + WS_DD), lds); } } }
    SEAM(3);
    if (IN(4)) { gla2_phase((const bf16*)(ws + WS_P), (const float*)(ws + WS_DD), (bf16*)(ws + WS_SS), vcu, G); }
    SEAM(4);
    if (IN(5)) { { GlaIn gin; int it = vcu; if (it < NB * NH * NCH) gla3_load<0>(gin, (it / NCH) >> 3, (it / NCH) & 7, it % NCH, (const bf16*)(ws + WS_Q), (const bf16*)(ws + WS_LFF), (const bf16*)(ws + WS_V), (const bf16*)(ws + WS_SS));
          for (; it < NB * NH * NCH; it += G) { const int tc = it % NCH, bh = it / NCH, nit = it + G; const bool hn = nit < NB * NH * NCH; const int nbh = hn ? nit / NCH : bh, ntc = hn ? nit % NCH : tc;
            gla3_item(gin, bh >> 3, bh & 7, tc, hn, nbh >> 3, nbh & 7, ntc, (const bf16*)(ws + WS_Q), (const bf16*)(ws + WS_LFF), (const bf16*)(ws + WS_LFB), (const bf16*)(ws + WS_V), (const bf16*)(ws + WS_SG),
                      (const bf16*)(ws + WS_SS), args.in[11], OM, lds); } } }
    SEAM(5);
    if (IN(6)) { pg8::Gemm g{OM, (const bf16*)(ws + WS_WHOUT), RT, 1024, 1024, nullptr}; pg8::TailOrder S; S.init(64, 4, G, bx, 64, 0, 2, 4);
        pg8::EpiResid E{args.in[0], args.in[2], MOD0 + 2 * 1024, XA};
        pg8::gemm_phase<pg8::EpiResid, pg8::TailOrder, true, true>(ldsL, g, S, E); }
    SEAM(6);
    if (IN(7)) { norm_phase<true>(XA, XA + (size_t)RL * 1024, RT, args.in[7], MOD0, 3, 4, H, args.in[17], AFF, ldsL, vcu, G); }
    SEAM(7);
    if (IN(8)) { for (int it = vcu; it < 64; it += G) topk_item(it >> 5, (it & 31) >> 4, it & 15, AFF, ROWIDX, SLOT, lds); bg_convert(args, ldsL, BG_WAVE, nullptr, G); }
    SEAM(8);
    if (IN(9)) { pg8::Gemm g{H, (const bf16*)(ws + WS_WGU0), NE * MROWS, NE * 5632, 1024, ROWIDX}; pg8::GroupedOrder S; S.init(22, G, bx, true, 1, 16);
        pg8::EpiMoe1 E{ACT}; pg8::gemm_phase<pg8::EpiMoe1, pg8::GroupedOrder, true, true, true>(ldsL, g, S, E); }
    SEAM(9);
    if (IN(10)) { pg8::Gemm g{ACT, (const bf16*)(ws + WS_WDN0), NE * MROWS, NE * 1024, FE, nullptr}; pg8::GroupedOrder S; S.init(4, G, bx, true, 2, 44);
        pg8::EpiMoe2 E{Y, Y2}; pg8::gemm_phase<pg8::EpiMoe2, pg8::GroupedOrder, true, true>(ldsL, g, S, E); }
    SEAM(10);
    if (IN(11)) { combine_phase<false>(XA, RT, SLOT, AFF, Y, Y2, MOD0, XB, args.in[6] + 1024, MOD1, H, nullptr, vcu, G); }
    SEAM(11);
    if (IN(12)) { pg8::Gemm g{H, (const bf16*)(ws + WS_WDIN), RT, 3072, 1024, nullptr}; pg8::TailOrder S; S.init(64, 12, G, bx, 64, 4, 2, 8);
        pg8::EpiDin E{(bf16*)(ws + WS_QA), (bf16*)(ws + WS_KA), (bf16*)(ws + WS_VA), ROPE, KMX};
        pg8::gemm_phase<pg8::EpiDin, pg8::TailOrder, true, true>(ldsL, g, S, E); }
    SEAM(12);
    if (IN(13)) {
        const int cslot = (int)(bx % 3);
        for (int i = 0;; ++i) { const int L = i * G + bx;
            if (i == cslot) { bg_convert(args, ldsL, 2 * BG_WAVE, nullptr, G); __syncthreads(); }
            if (L >= 512) break;
            int qb, grp; if (G == 256) { qb = bx >> 3; grp = i * 8 + (bx & 7); } else { qb = L & 31; grp = L >> 5; }
            attn_item((const bf16*)(ws + WS_QA), (const bf16*)(ws + WS_KA), (const bf16*)(ws + WS_VA), OM, KMX, LAM, args.in[15], grp >> 3, grp & 7, qb, lds); } }
    SEAM(13);
    if (IN(14)) { pg8::Gemm g{OM, (const bf16*)(ws + WS_WDOUT), RL, 1024, 1024, nullptr}; pg8::StaticOrder S; S.init(RL, 1024, G, bx);
        pg8::EpiResid E{XB, XB + (size_t)RL * 1024, MOD1 + 2 * 1024, XA};
        pg8::gemm_phase<pg8::EpiResid, pg8::StaticOrder, true, true>(ldsL, g, S, E); }
    SEAM(14);
    if (IN(15)) { norm_phase<true>(XA, XA + (size_t)RL * 1024, RL, args.in[7] + 1024, MOD1, 3, 4, H, args.in[17] + 16384, AFF, ldsL, vcu, G); }
    SEAM(15);
    if (IN(16)) { for (int it = vcu; it < 32; it += G) topk_item(0, it >> 4, it & 15, AFF, ROWIDX, SLOT, lds); bg_convert(args, ldsL, 2 * BG_WAVE, nullptr, G); }
    SEAM(16);
    if (IN(17)) { pg8::Gemm g{H, (const bf16*)(ws + WS_WGU1), NE * MROWS, NE * 5632, 1024, ROWIDX}; pg8::GroupedOrder S; S.init(22, G, bx, false, 1, 16);
        pg8::EpiMoe1 E{ACT}; pg8::gemm_phase<pg8::EpiMoe1, pg8::GroupedOrder, true, true, true>(ldsL, g, S, E); }
    SEAM(17);
    if (IN(18)) { pg8::Gemm g{ACT, (const bf16*)(ws + WS_WDN1), NE * MROWS, NE * 1024, FE, nullptr}; pg8::GroupedOrder S; S.init(4, G, bx, false, 1, 44);
        pg8::EpiMoe2 E{Y, Y2}; pg8::gemm_phase<pg8::EpiMoe2, pg8::GroupedOrder, true, true>(ldsL, g, S, E); }
    SEAM(18);
    if (IN(19)) { combine_phase<true>(XA, RL, SLOT, AFF, Y, Y2, MOD1, nullptr, args.in[8], nullptr, nullptr, args.out, vcu, G); }
#undef IN
#undef SEAM
}
extern "C" void kernel_launch(void* const* d_in, const int* in_sizes, int n_in, void* d_out, int out_size, void* d_ws, size_t ws_size, hipStream_t stream) {
    static int grid = 0;
    if (grid == 0) {
        if (n_in != 21 || out_size != RL * DM || ws_size < WS_END) { fprintf(stderr, "kernel_launch: unexpected shapes: n_in %d out %d ws %zu (need %zu)\n", n_in, out_size, ws_size, (size_t)WS_END); grid = -1; return; }
        int dev = 0, cus = 0;
        if (hipGetDevice(&dev) != hipSuccess || hipDeviceGetAttribute(&cus, hipDeviceAttributeMultiprocessorCount, dev) != hipSuccess) { grid = -1; return; }
        if (hipFuncSetAttribute((const void*)mk_fwd, hipFuncAttributeMaxDynamicSharedMemorySize, LDS_BYTES) != hipSuccess) { fprintf(stderr, "kernel_launch: hipFuncSetAttribute failed\n"); grid = -1; return; }
        int per_cu = 0;
        if (hipOccupancyMaxActiveBlocksPerMultiprocessor(&per_cu, (const void*)mk_fwd, NWAVES * 64, LDS_BYTES) != hipSuccess || per_cu < 1) fprintf(stderr, "kernel_launch: occupancy query says %d\n", per_cu);
        (void)hipGetLastError();
        grid = cus;
    }
    if (grid < 0) return;
    (void)hipMemsetAsync((char*)d_ws + WS_CTL, 0, CTL_ZERO_BYTES, stream);
    Args a{};
    for (int i = 0; i < 21; ++i) a.in[i] = (const float*)d_in[i];
    a.out = (float*)d_out; a.ws = (unsigned char*)d_ws;
#if MK_MULTI
    for (int ph = 0; ph < NPHASES; ++ph) { a.ph_lo = ph; a.ph_hi = ph + 1; hipLaunchKernelGGL(mk_fwd, dim3(grid), dim3(NWAVES * 64), LDS_BYTES, stream, a); }
#else
    a.ph_lo = 0; a.ph_hi = NPHASES; hipLaunchKernelGGL(mk_fwd, dim3(grid), dim3(NWAVES * 64), LDS_BYTES, stream, a);
#endif
    const hipError_t le = hipPeekAtLastError();
    if (le != hipSuccess) fprintf(stderr, "kernel_launch: launch failed: %s\n", hipGetErrorName(le));
}
```
